# Optimizing an MI355X kernel written in HIP

```python
import math
import jax, jax.numpy as jnp
from jax import lax
import numpy as np

D_MODEL = 2048
BATCH = 4
SEQ = 4096
DEPTH = 2

D_FF = 5632
FFN_RES = 0.5
ATTN_HEADS = 8
ATTN_KV_HEADS = 2
ATTN_HEAD_DIM = 128
ATTN_REP = ATTN_HEADS // ATTN_KV_HEADS
IDX_HEADS = 16
IDX_HEAD_DIM = 64
TOPK_MAX = 256
Q_BLOCK = 128
GLA_HEADS = 4
GLA_DK = 128
GLA_DV = 256
GLA_GATE_RANK = 16
GLA_GATE_NORM = 16.0
GLA_CHUNK = 64
ROPE_THETA = 500000.0
ATTN_ROT = ATTN_HEAD_DIM // 4
IDX_ROT = IDX_HEAD_DIM // 4
EPS = 1e-6
NEG_INF = -1e30

ATTN_Q = ATTN_HEADS * ATTN_HEAD_DIM
ATTN_KV = ATTN_KV_HEADS * ATTN_HEAD_DIM
IDX_Q = IDX_HEADS * IDX_HEAD_DIM
GLA_K = GLA_HEADS * GLA_DK
GLA_V = GLA_HEADS * GLA_DV
IN_SPLITS = (ATTN_Q, ATTN_KV, ATTN_KV, IDX_Q, IDX_HEAD_DIM, IDX_HEADS,
             GLA_K, GLA_K, GLA_V, GLA_GATE_RANK, GLA_V, D_MODEL, D_MODEL)
IN_COLS = int(sum(IN_SPLITS))
IN_OFFSETS = tuple(int(v) for v in np.cumsum(IN_SPLITS)[:-1])

kernel_name = "hybrid_dsa_gla_macaron"


def rmsnorm(x, g):
    xf = x.astype(jnp.float32)
    xf = xf * lax.rsqrt(jnp.mean(xf * xf, axis=-1, keepdims=True) + EPS)
    return (xf * g.astype(jnp.float32)).astype(x.dtype)


def swiglu(h, w_gate, w_up, w_down):
    return (jax.nn.silu(h @ w_gate) * (h @ w_up)) @ w_down


def rope_tables(length, rot):
    inv = ROPE_THETA ** (-jnp.arange(0, rot, 2, dtype=jnp.float32) / rot)
    ang = jnp.arange(length, dtype=jnp.float32)[:, None] * inv[None, :]
    return jnp.cos(ang), jnp.sin(ang)


def rope_partial(x, cos, sin):
    half = cos.shape[-1]
    x1, x2, xp = x[..., :half], x[..., half:2 * half], x[..., 2 * half:]
    c, s = cos[None, :, None, :], sin[None, :, None, :]
    return jnp.concatenate([x1 * c - x2 * s, x2 * c + x1 * s, xp], axis=-1).astype(x.dtype)


def dsa_attention(q, k, v, qi, ki, wi):
    B, L = q.shape[0], q.shape[1]
    nb = L // Q_BLOCK
    topk = min(TOPK_MAX, L // 4)
    keypos = jnp.arange(L, dtype=jnp.int32)
    ki32 = ki.astype(jnp.float32)
    gather = jax.vmap(lambda kv_b, idx_b: kv_b[idx_b])

    def to_blocks(a):
        return jnp.moveaxis(a.reshape((B, nb, Q_BLOCK) + a.shape[2:]), 1, 0)

    def block(args):
        start, qb, qib, wb = args
        t = start + jnp.arange(Q_BLOCK, dtype=jnp.int32)
        rel = jax.nn.relu(jnp.einsum('bqhd,bsd->bqhs', qib.astype(jnp.float32), ki32)
                          * (IDX_HEAD_DIM ** -0.5))
        score = jnp.einsum('bqhs,bqh->bqs', rel, wb.astype(jnp.float32))
        causal = keypos[None, :] <= t[:, None]
        score = jnp.where(causal[None], score, NEG_INF)
        _, sel = lax.top_k(score, topk)
        k_sel = gather(k, sel)
        v_sel = gather(v, sel)
        qg = qb.reshape(B, Q_BLOCK, ATTN_KV_HEADS, ATTN_REP, ATTN_HEAD_DIM)
        s = jnp.einsum('bqgrd,bqkgd->bqgrk', qg, k_sel).astype(jnp.float32) * (ATTN_HEAD_DIM ** -0.5)
        valid = sel <= t[None, :, None]
        s = jnp.where(valid[:, :, None, None, :], s, NEG_INF)
        p = jax.nn.softmax(s, axis=-1).astype(v.dtype)
        o = jnp.einsum('bqgrk,bqkgd->bqgrd', p, v_sel)
        return o.reshape(B, Q_BLOCK, ATTN_Q)

    starts = jnp.arange(nb, dtype=jnp.int32) * Q_BLOCK
    out = lax.map(block, (starts, to_blocks(q), to_blocks(qi), to_blocks(wi)))
    return jnp.moveaxis(out, 0, 1).reshape(B, L, ATTN_Q)


def gla_chunked(q, k, v, log_a):
    B, L, H, dk = q.shape
    dv = v.shape[-1]
    C = GLA_CHUNK
    n = L // C

    def chunks(a):
        return a.reshape(B, n, C, H, a.shape[-1]).transpose(0, 3, 1, 2, 4).astype(jnp.float32)

    q = chunks(q) * (dk ** -0.5)
    k, v, g = chunks(k), chunks(v), chunks(log_a)
    b = jnp.cumsum(g, axis=3)
    b_last = b[:, :, :, -1:, :]
    qe = q * jnp.exp(b - b_last)
    kd = k * jnp.exp(b_last - b)
    tri = jnp.tril(jnp.ones((C, C), dtype=bool))
    A = jnp.where(tri, jnp.einsum('bhnid,bhnjd->bhnij', qe, kd), 0.0)
    o_intra = jnp.einsum('bhnij,bhnje->bhnie', A, v)
    kv = jnp.einsum('bhnjd,bhnje->bhnde', kd, v)
    decay = jnp.exp(b_last[:, :, :, 0, :])

    def step(state, inp):
        kv_n, dec_n = inp
        return dec_n[..., None] * state + kv_n, state

    s0 = jnp.zeros((B, H, dk, dv), jnp.float32)
    _, s_prev = lax.scan(step, s0, (jnp.moveaxis(kv, 2, 0), jnp.moveaxis(decay, 2, 0)))
    s_prev = jnp.moveaxis(s_prev, 0, 2)
    o_inter = jnp.einsum('bhnid,bhnde->bhnie', q * jnp.exp(b), s_prev)
    o = o_intra + o_inter
    return o.transpose(0, 2, 3, 1, 4).reshape(B, L, H, dv)


def mixer(h, w_in, gla_w_a2, gla_b_a, gla_norm, w_up_attn, w_up_gla, w_out, cos_a, sin_a, cos_i, sin_i):
    B, L, _ = h.shape
    proj = h @ w_in
    (aq, ak, av, iq, ik, iw, gq, gk, gv, ga, gr, m_a, m_g) = jnp.split(proj, IN_OFFSETS, axis=-1)
    aq = rope_partial(aq.reshape(B, L, ATTN_HEADS, ATTN_HEAD_DIM), cos_a, sin_a)
    ak = rope_partial(ak.reshape(B, L, ATTN_KV_HEADS, ATTN_HEAD_DIM), cos_a, sin_a)
    av = av.reshape(B, L, ATTN_KV_HEADS, ATTN_HEAD_DIM)
    iq = rope_partial(iq.reshape(B, L, IDX_HEADS, IDX_HEAD_DIM), cos_i, sin_i)
    ik = rope_partial(ik.reshape(B, L, 1, IDX_HEAD_DIM), cos_i, sin_i)[:, :, 0]
    iw = iw * (IDX_HEADS ** -0.5)
    o_attn = dsa_attention(aq, ak, av, iq, ik, iw)
    log_a = jax.nn.log_sigmoid((ga @ gla_w_a2 + gla_b_a).astype(jnp.float32)) / GLA_GATE_NORM
    o_g = gla_chunked(gq.reshape(B, L, GLA_HEADS, GLA_DK), gk.reshape(B, L, GLA_HEADS, GLA_DK),
                      gv.reshape(B, L, GLA_HEADS, GLA_DV), log_a.reshape(B, L, GLA_HEADS, GLA_DK))
    o_g = rmsnorm(o_g, gla_norm) * jax.nn.silu(gr.reshape(B, L, GLA_HEADS, GLA_DV).astype(jnp.float32))
    o_g = o_g.reshape(B, L, GLA_V).astype(h.dtype)
    y = jax.nn.sigmoid(m_a) * (o_attn @ w_up_attn) + jax.nn.sigmoid(m_g) * (o_g @ w_up_gla)
    return y @ w_out


def setup_inputs(seed: int = 0) -> dict:
    key = jax.random.key(seed)
    ks = jax.random.split(key, 20)

    def dense(k, shape, fan_in):
        return jax.random.normal(k, shape, jnp.float32) * (fan_in ** -0.5)

    def gain(k, shape):
        return 1.0 + 0.01 * jax.random.normal(k, shape, jnp.float32)

    D, F = D_MODEL, D_FF
    return {
        "x": jax.random.normal(ks[0], (BATCH, SEQ, D), jnp.float32),
        "ffn1_norm": gain(ks[1], (DEPTH, D)),
        "ffn1_w_gate": dense(ks[2], (DEPTH, D, F), D),
        "ffn1_w_up": dense(ks[3], (DEPTH, D, F), D),
        "ffn1_w_down": dense(ks[4], (DEPTH, F, D), F),
        "mix_norm": gain(ks[5], (DEPTH, D)),
        "w_in": dense(ks[6], (DEPTH, D, IN_COLS), D),
        "gla_w_a2": dense(ks[7], (DEPTH, GLA_GATE_RANK, GLA_K), GLA_GATE_RANK),
        "gla_b_a": 0.01 * jax.random.normal(ks[8], (DEPTH, GLA_K), jnp.float32),
        "gla_norm": gain(ks[9], (DEPTH, GLA_DV)),
        "w_up_attn": dense(ks[10], (DEPTH, ATTN_Q, D), ATTN_Q),
        "w_up_gla": dense(ks[11], (DEPTH, GLA_V, D), GLA_V),
        "w_out": dense(ks[12], (DEPTH, D, D), D),
        "ffn2_norm": gain(ks[13], (DEPTH, D)),
        "ffn2_w_gate": dense(ks[14], (DEPTH, D, F), D),
        "ffn2_w_up": dense(ks[15], (DEPTH, D, F), D),
        "ffn2_w_down": dense(ks[16], (DEPTH, F, D), F),
        "final_norm": gain(ks[17], (D,)),
    }


def reference(x, ffn1_norm, ffn1_w_gate, ffn1_w_up, ffn1_w_down, mix_norm, w_in, gla_w_a2, gla_b_a,
              gla_norm, w_up_attn, w_up_gla, w_out, ffn2_norm, ffn2_w_gate, ffn2_w_up, ffn2_w_down,
              final_norm):
    L = x.shape[1]
    cos_a, sin_a = rope_tables(L, ATTN_ROT)
    cos_i, sin_i = rope_tables(L, IDX_ROT)
    for l in range(DEPTH):
        x = x + FFN_RES * swiglu(rmsnorm(x, ffn1_norm[l]), ffn1_w_gate[l], ffn1_w_up[l], ffn1_w_down[l])
        x = x + mixer(rmsnorm(x, mix_norm[l]), w_in[l], gla_w_a2[l], gla_b_a[l], gla_norm[l],
                      w_up_attn[l], w_up_gla[l], w_out[l], cos_a, sin_a, cos_i, sin_i)
        x = x + FFN_RES * swiglu(rmsnorm(x, ffn2_norm[l]), ffn2_w_gate[l], ffn2_w_up[l], ffn2_w_down[l])
    return rmsnorm(x, final_norm)
```

```cpp
#include <hip/hip_runtime.h>
#include <cstdio>
#include <cstdint>

#ifndef MK_PER_PHASE
#define MK_PER_PHASE 0
#endif

#define LAS __attribute__((address_space(3)))
#define GAS __attribute__((address_space(1)))
typedef unsigned short bf16_t;
typedef short bf16x8 __attribute__((ext_vector_type(8)));
typedef float f32x4 __attribute__((ext_vector_type(4)));
typedef float f32x16 __attribute__((ext_vector_type(16)));
typedef unsigned u32x4 __attribute__((ext_vector_type(4)));
typedef unsigned u32x2 __attribute__((ext_vector_type(2)));

constexpr int NB = 4, SEQ = 4096, DM = 2048, NT = NB * SEQ, DFF = 5632;
constexpr int N_UP = 2 * DFF;
constexpr int N_IN = 9984;
constexpr float EPS = 1e-6f;
constexpr int OFF_AQ = 0, OFF_AK = 1024, OFF_AV = 1280, OFF_IQ = 1536, OFF_IK = 2560, OFF_IW = 2624, OFF_GQ = 2640, OFF_GK = 3152, OFF_GV = 3664,
              OFF_GA = 4688, OFF_GR = 4704, OFF_MA = 5728, OFF_MG = 7776, IN_COLS = 9824;

constexpr size_t MiB = 1048576;
constexpr size_t WS_CTL = 0, CTL_BYTES = 1 * MiB;
constexpr size_t CTL_SSQ = 65536;
constexpr int    CW_BAR = 4096;
constexpr size_t WS_TAB = 1 * MiB;
constexpr size_t WS_WUP1 = 2 * MiB, WS_WDN1 = 46 * MiB, WS_WIN = 68 * MiB, WS_WUA = 107 * MiB, WS_WUG = 111 * MiB, WS_WOUT = 115 * MiB, WS_WUP2 = 123 * MiB, WS_WDN2 = 167 * MiB;
constexpr size_t WS_XB = 189 * MiB;
constexpr size_t WS_ACT = 253 * MiB;
constexpr size_t WS_AQ = 253 * MiB, WS_AK = 285 * MiB, WS_AV = 293 * MiB, WS_IQ = 301 * MiB, WS_IK = 333 * MiB, WS_IW = 335 * MiB, WS_GA = 336 * MiB, WS_GQ = 337 * MiB,
                 WS_GK = 353 * MiB, WS_GV = 369 * MiB, WS_GR = 401 * MiB, WS_SA = 433 * MiB  , WS_SG = 497 * MiB;
constexpr size_t WS_OATT = 561 * MiB, WS_OG = 593 * MiB, WS_OGRAW = 625 * MiB  , WS_SEL = 689 * MiB;
constexpr size_t WS_QB = 697 * MiB, WS_KDT = 713 * MiB, WS_VT = 729 * MiB, WS_ATF = 761 * MiB, WS_DEC = 769 * MiB;
constexpr size_t WS_AVT = WS_SEL;
constexpr size_t WS_MASK = 770 * MiB, WS_SCR = 786 * MiB, WS_END = 850 * MiB;

constexpr int LDS_STAGE = 131072, LDS_RS = LDS_STAGE + 1024  , LDS_BYTES = LDS_RS + 12288;

typedef __bf16 bf16x2_t __attribute__((ext_vector_type(2)));
typedef float f32x2_t __attribute__((ext_vector_type(2)));
typedef float f32x2 __attribute__((ext_vector_type(2)));
__device__ __forceinline__ unsigned cvt_pk_bf16(float lo, float hi) { const f32x2_t v = {lo, hi}; return __builtin_bit_cast(unsigned, __builtin_convertvector(v, bf16x2_t)); }
__device__ __forceinline__ unsigned f2bf(float f) { unsigned u = __builtin_bit_cast(unsigned, f); return (u + 0x7fffu + ((u >> 16) & 1u)) >> 16; }
__device__ __forceinline__ float bf2f(unsigned b) { return __builtin_bit_cast(float, b << 16); }
__device__ __forceinline__ float bflo(unsigned w) { return __builtin_bit_cast(float, w << 16); }
__device__ __forceinline__ float bfhi(unsigned w) { return __builtin_bit_cast(float, w & 0xffff0000u); }
__device__ __forceinline__ float silu_f(float x) { return x * __builtin_amdgcn_rcpf(1.f + __builtin_amdgcn_exp2f(-1.4426950408889634f * x)); }
__device__ __forceinline__ float sigmoid_f(float x) { return __builtin_amdgcn_rcpf(1.f + __builtin_amdgcn_exp2f(-1.4426950408889634f * x)); }
__device__ __forceinline__ float wave_sum(float v) {
#pragma unroll
    for (int o = 1; o < 64; o <<= 1) v += __shfl_xor(v, o);
    return v;
}
__device__ __forceinline__ int lane_id_fresh() { int x; asm volatile("v_mbcnt_lo_u32_b32 %0, -1, 0\n\tv_mbcnt_hi_u32_b32 %0, -1, %0" : "=v"(x)); return x; }
#define VM_WAIT() asm volatile("s_waitcnt vmcnt(0)" ::: "memory")
#define LDS_WAIT() asm volatile("s_waitcnt lgkmcnt(0)" ::: "memory")

#define XB_TMO      128
#define XB_XCNT(j)  (256  + 64 * (j))
#define XB_XSUB(j)  (1280 + 64 * (j))
#define XB_XGEN(j)  (2304 + 64 * (j))
#define XB_TOP      3328
#define XB_TOPGEN   3392
#define XCD_BAR_WORDS 3456
#define XB_SPIN_CAP (1u << 18)

__device__ __forceinline__ unsigned xb_ld(GAS unsigned* p)              { return __hip_atomic_load(p, __ATOMIC_RELAXED, __HIP_MEMORY_SCOPE_AGENT); }
__device__ __forceinline__ unsigned xb_add(GAS unsigned* p, unsigned v) { return __hip_atomic_fetch_add(p, v, __ATOMIC_RELAXED, __HIP_MEMORY_SCOPE_AGENT); }
__device__ __forceinline__ unsigned xb_xcc_id() { return (unsigned)__builtin_amdgcn_s_getreg((3 << 11) | 20) & 0xFu; }
#define XB_SPIN(cond, bar) do { unsigned _sp = 0; while (cond) { __builtin_amdgcn_s_sleep(1); \
    if ((++_sp & 255u) == 0u) { if (xb_ld(&(bar)[XB_TMO])) break; if (_sp > XB_SPIN_CAP) { xb_add(&(bar)[XB_TMO], 1u); break; } } } } while (0)

struct XcdBarrier { GAS unsigned* bar; unsigned x; volatile LAS unsigned* st; };

__device__ __forceinline__ XcdBarrier xcd_barrier_post(GAS unsigned* bar, volatile LAS unsigned* st) {
    XcdBarrier b; b.bar = bar; b.x = xb_xcc_id(); b.st = st;
    if (threadIdx.x == 0) (void)xb_add(&bar[XB_XCNT(b.x)], 1u);
    return b;
}
__device__ __forceinline__ void xcd_barrier_complete(GAS unsigned* bar, unsigned x, unsigned& nloc, unsigned& nx) {
    const unsigned G = gridDim.x * gridDim.y * gridDim.z;
    unsigned sum, cnt, mine, sp = 0u;
    for (;;) {
        sum = 0u; cnt = 0u; mine = 0u;
#pragma unroll
        for (unsigned j = 0; j < 16; ++j) { const unsigned c = xb_ld(&bar[XB_XCNT(j)]); sum += c; cnt += (c > 0u) ? 1u : 0u; mine = (j == x) ? c : mine; }
        if (sum == G) break;
        __builtin_amdgcn_s_sleep(1);
        if ((++sp & 255u) == 0u) { if (xb_ld(&bar[XB_TMO])) break; if (sp > XB_SPIN_CAP) { xb_add(&bar[XB_TMO], 1u); break; } }
    }
    nloc = mine > 0u ? mine : 1u; nx = cnt > 0u ? cnt : 1u;
}
__device__ __forceinline__ void xcd_barrier(const XcdBarrier& b, const int tid_) {
    asm volatile("s_waitcnt vmcnt(0)" ::: "memory");
    __syncthreads();
    if (tid_ == 0) {
        GAS unsigned* bar = b.bar;
        __builtin_amdgcn_s_waitcnt(0);
        unsigned nloc = b.st[0], nx = b.st[1];
        if (nloc == 0u) { xcd_barrier_complete(bar, b.x, nloc, nx); b.st[0] = nloc; b.st[1] = nx; }
        const unsigned old = xb_add(&bar[XB_XSUB(b.x)], 1u);
        const unsigned gen = old / nloc;
        if (old + 1u == (gen + 1u) * nloc) {
            __builtin_amdgcn_fence(__ATOMIC_RELEASE, "agent");
            asm volatile("s_waitcnt vmcnt(0)" ::: "memory");
            const unsigned og = xb_add(&bar[XB_TOP], 1u);
            const unsigned tg = og / nx;
            if (og + 1u == (tg + 1u) * nx) xb_add(&bar[XB_TOPGEN], 1u);
            else XB_SPIN(xb_ld(&bar[XB_TOPGEN]) == tg, bar);
            __builtin_amdgcn_fence(__ATOMIC_ACQUIRE, "agent");
            xb_add(&bar[XB_XGEN(b.x)], 1u);
            asm volatile("s_waitcnt vmcnt(0)" ::: "memory");
        } else {
            XB_SPIN(xb_ld(&bar[XB_XGEN(b.x)]) == gen, bar);
            __builtin_amdgcn_fence(__ATOMIC_ACQUIRE, "agent");
            asm volatile("s_waitcnt vmcnt(0)" ::: "memory");
        }
    }
    __syncthreads();
}

namespace pg8 {
constexpr int BM = 256, BK = 64, HALF = 128, HTB = HALF * BK * 2, STAGE_BYTES = 8 * HTB, NXCD = 8, WGM = 8;
__host__ __device__ __forceinline__ int lds_byte(int r, int c) { const int st = (r >> 4) * 2 + (c >> 5), rr = r & 15, cc = c & 31, ob = rr * 64 + cc * 2; return st * 1024 + (ob ^ (((ob >> 9) & 1) << 5)); }
__host__ __device__ __forceinline__ void stage_rc(int b, int& R, int& C) { const int st = b / 1024, sb = b % 1024, swz = sb ^ (((sb >> 9) & 1) << 5); R = (st >> 1) * 16 + swz / 64; C = (st & 1) * 32 + (swz % 64) / 2; }
__host__ __device__ __forceinline__ int perm32(int rho) { const int n = rho >> 4, i = rho & 15; return 8 * (i >> 2) + 4 * n + (i & 3); }
struct Unit { int pm, pn; };
struct Gemm { const GAS bf16_t* A; const GAS bf16_t* Bt; int M, N, K; };
struct StaticOrder {
    int nM, nN, nwg, G, c;
    __device__ void init(int M, int N, int G_, int c_) { nM = M / BM; nN = N / BM; nwg = nM * nN; G = G_; c = c_; }
    __device__ bool next(int i, Unit& u) const {
        const long L = (long)i * G + c; if (L >= nwg) return false;
        int wgid = (int)L; { const int q = nwg / NXCD, r = nwg % NXCD, xcd = wgid % NXCD, off = wgid / NXCD; wgid = (xcd < r ? xcd * (q + 1) : r * (q + 1) + (xcd - r) * q) + off; }
        const int nig = WGM * nN, gid = wgid / nig, fm = gid * WGM, gsz = (nM - fm) < WGM ? (nM - fm) : WGM;
        u.pm = fm + ((wgid % nig) % gsz); u.pn = (wgid % nig) / gsz; return true;
    }
};
template <class Epi>
__device__ __forceinline__ void gemm_phase(LAS unsigned char* lds, const Gemm g, const StaticOrder& S, const Epi& E, const int tid) {
    const int wid = __builtin_amdgcn_readfirstlane(tid >> 6), lane = tid & 63, wr = wid >> 2, wc = wid & 3, fr = lane & 15, fq = lane >> 4;
    const int K = g.K, nt = K / BK;
    unsigned voffA[2], voffB[2];
#pragma unroll
    for (int i = 0; i < 2; ++i) { int R, C; stage_rc(tid * 16 + i * 8192, R, C); const int Rb = (R & ~31) + perm32(R & 31);
        voffA[i] = (unsigned)(R * K + C) * 2u; voffB[i] = (unsigned)(Rb * BK + C) * 2u; }
    const size_t kstep = (size_t)(BK * 2);
    const size_t hstep = (size_t)HALF * K * 2;
    const size_t tstep = 2 * hstep;
    const size_t kstepB = (size_t)BM * BK * 2, hstepB = (size_t)HALF * BK * 2;
    const unsigned ldsw = (unsigned)wid * 1024u;
    const int aoff = lds_byte(wr * 64 + fr, fq * 8), boff = lds_byte(wc * 32 + fr, fq * 8);
#define PG8_SA(b, h) (((b) * 2 + (h)) * HTB)
#define PG8_SB(b, h) ((4 + (b) * 2 + (h)) * HTB)
#define PG8_STAGE(bufoff, gbase, voff) do { _Pragma("unroll") for (int _i = 0; _i < 2; ++_i) \
        __builtin_amdgcn_global_load_lds((const GAS unsigned*)((const GAS char*)(gbase) + (voff)[_i]), (LAS unsigned*)(lds + (bufoff) + ldsw + _i * 8192), 16, 0, 0); } while (0)
#define PG8_LDA(dst, b, h) do { _Pragma("unroll") for (int m = 0; m < 4; ++m) _Pragma("unroll") for (int k = 0; k < 2; ++k) dst[m][k] = *(const LAS bf16x8*)(lds + PG8_SA(b, h) + aoff + m * 2048 + k * 1024); } while (0)
#define PG8_LDB(dst, b, h) do { _Pragma("unroll") for (int n = 0; n < 2; ++n) _Pragma("unroll") for (int k = 0; k < 2; ++k) dst[n][k] = *(const LAS bf16x8*)(lds + PG8_SB(b, h) + boff + n * 2048 + k * 1024); } while (0)
#define PG8_MMA(ai, bj, At, Bt) do { __builtin_amdgcn_s_setprio(1); _Pragma("unroll") for (int m = 0; m < 4; ++m) _Pragma("unroll") for (int n = 0; n < 2; ++n) _Pragma("unroll") for (int k = 0; k < 2; ++k) \
        acc[ai][bj][m][n] = __builtin_amdgcn_mfma_f32_16x16x32_bf16(Bt[n][k], At[m][k], acc[ai][bj][m][n], 0, 0, 0); __builtin_amdgcn_s_setprio(0); } while (0)
#define PG8_WAIT_V(n) asm volatile("s_waitcnt vmcnt(" #n ")" ::: "memory")
#define PG8_WAIT_L(n) asm volatile("s_waitcnt lgkmcnt(" #n ")" ::: "memory")
#define PG8_BAR __builtin_amdgcn_s_barrier()
#define PG8_SCHED __builtin_amdgcn_sched_barrier(0)
    Unit cur, nxt; int ui = 0;
    if (!S.next(0, cur)) return;
    f32x4 acc[2][2][4][2];
#pragma unroll
    for (int a = 0; a < 2; ++a)
#pragma unroll
        for (int b = 0; b < 2; ++b)
#pragma unroll
            for (int m = 0; m < 4; ++m)
#pragma unroll
                for (int n = 0; n < 2; ++n) acc[a][b][m][n] = (f32x4){0.f, 0.f, 0.f, 0.f};
    bf16x8 At[4][2], B0[2][2], B1[2][2];
    const GAS char* cA = (const GAS char*)g.A + (size_t)cur.pm * tstep; const GAS char* cB = (const GAS char*)g.Bt + (size_t)cur.pn * tstep;
    PG8_STAGE(PG8_SB(0, 0), cB, voffB); PG8_STAGE(PG8_SA(0, 0), cA, voffA); PG8_STAGE(PG8_SB(0, 1), cB + hstepB, voffB); PG8_STAGE(PG8_SA(0, 1), cA + hstep, voffA);
    if (wr == 1) PG8_BAR;
    PG8_WAIT_V(4); PG8_BAR;
    PG8_STAGE(PG8_SB(1, 0), cB + kstepB, voffB); PG8_STAGE(PG8_SA(1, 0), cA + kstep, voffA); PG8_STAGE(PG8_SB(1, 1), cB + hstepB + kstepB, voffB);
    PG8_WAIT_V(6); PG8_BAR;
    for (;;) {
        const bool has_next = S.next(ui + 1, nxt);
        const GAS char* nA = has_next ? (const GAS char*)g.A + (size_t)nxt.pm * tstep : cA; const GAS char* nB = has_next ? (const GAS char*)g.Bt + (size_t)nxt.pn * tstep : cB;
        for (int t = 0; t < nt; t += 2) {
            const bool last = (t == nt - 2);
            const GAS char* a1 = cA + (size_t)(t + 1) * kstep;
            const GAS char* a2 = last ? nA : cA + (size_t)(t + 2) * kstep; const GAS char* b2 = last ? nB : cB + (size_t)(t + 2) * kstepB;
            const GAS char* a3 = a2 + kstep; const GAS char* b3 = b2 + kstepB;
            PG8_LDB(B0, 0, 0); PG8_SCHED; PG8_LDA(At, 0, 0); PG8_STAGE(PG8_SA(1, 1), a1 + hstep, voffA);
            PG8_WAIT_L(8); PG8_BAR; PG8_WAIT_L(0); PG8_MMA(0, 0, At, B0); PG8_BAR; PG8_SCHED;
            PG8_LDB(B1, 0, 1); PG8_STAGE(PG8_SB(0, 0), b2, voffB);
            PG8_BAR; PG8_WAIT_L(0); PG8_MMA(0, 1, At, B1); PG8_BAR;
            PG8_LDA(At, 0, 1); PG8_STAGE(PG8_SA(0, 0), a2, voffA);
            PG8_BAR; PG8_WAIT_L(0); PG8_MMA(1, 0, At, B0); PG8_BAR; PG8_SCHED;
            PG8_STAGE(PG8_SB(0, 1), b2 + hstepB, voffB);
            PG8_WAIT_V(6); PG8_BAR; PG8_MMA(1, 1, At, B1); PG8_BAR;
            PG8_LDB(B0, 1, 0); PG8_SCHED; PG8_LDA(At, 1, 0); PG8_STAGE(PG8_SA(0, 1), a2 + hstep, voffA);
            PG8_WAIT_L(8); PG8_BAR; PG8_WAIT_L(0); PG8_MMA(0, 0, At, B0); PG8_BAR; PG8_SCHED;
            PG8_LDB(B1, 1, 1); PG8_STAGE(PG8_SB(1, 0), b3, voffB);
            PG8_BAR; PG8_WAIT_L(0); PG8_MMA(0, 1, At, B1); PG8_BAR;
            PG8_LDA(At, 1, 1); PG8_STAGE(PG8_SA(1, 0), a3, voffA);
            PG8_BAR; PG8_WAIT_L(0); PG8_MMA(1, 0, At, B0); PG8_BAR; PG8_SCHED;
            PG8_STAGE(PG8_SB(1, 1), b3 + hstepB, voffB);
            PG8_WAIT_V(6); PG8_BAR; PG8_MMA(1, 1, At, B1); PG8_BAR;
        }
        E(acc, cur, ui, wr, wc, fr, fq);
        if (!has_next) break;
#pragma unroll
        for (int a = 0; a < 2; ++a)
#pragma unroll
            for (int b = 0; b < 2; ++b)
#pragma unroll
                for (int m = 0; m < 4; ++m)
#pragma unroll
                    for (int n = 0; n < 2; ++n) acc[a][b][m][n] = (f32x4){0.f, 0.f, 0.f, 0.f};
        cur = nxt; cA = nA; cB = nB; ++ui;
    }
    PG8_WAIT_V(0);
    if (wr == 0) PG8_BAR;
    PG8_BAR;
#undef PG8_SA
#undef PG8_SB
#undef PG8_STAGE
#undef PG8_LDA
#undef PG8_LDB
#undef PG8_MMA
#undef PG8_WAIT_V
#undef PG8_WAIT_L
#undef PG8_BAR
#undef PG8_SCHED
}
}

typedef f32x4 AccT[2][2][4][2];

typedef unsigned long long u64;
__device__ __forceinline__ float ssq_val(const GAS u64* ssq, int r) { return (float)((double)ssq[r] * 5.9604644775390625e-08); }
__device__ __forceinline__ u64 ssq_fix(float s) { return (u64)(long long)(s * 16777216.0f); }
__device__ __forceinline__ float rstd_of(const GAS u64* ssq, int r) { return rsqrtf(ssq_val(ssq, r) * (1.0f / DM) + EPS); }

__device__ __forceinline__ void fill_rs(LAS float* rsl, const GAS u64* ssq, const pg8::StaticOrder& S, int tid) {
    pg8::Unit u;
    for (int i = 0; S.next(i, u); ++i) if (tid < 256) rsl[i * 256 + tid] = rstd_of(ssq, u.pm * 256 + tid);
    __syncthreads();
}
__device__ __forceinline__ u32x4 pack8(const f32x4 a, const f32x4 b) { u32x4 w; w.x = cvt_pk_bf16(a[0], a[1]); w.y = cvt_pk_bf16(a[2], a[3]); w.z = cvt_pk_bf16(b[0], b[1]); w.w = cvt_pk_bf16(b[2], b[3]); return w; }
__device__ __forceinline__ void unpack8(const u32x4 w, f32x4& a, f32x4& b) { a = (f32x4){bflo(w.x), bfhi(w.x), bflo(w.y), bfhi(w.y)}; b = (f32x4){bflo(w.z), bfhi(w.z), bflo(w.w), bfhi(w.w)}; }

struct EpiUp {
    GAS bf16_t* act; const LAS float* rs;
    __device__ __forceinline__ void operator()(const AccT& acc, const pg8::Unit& u, int ui, int wr, int wc, int fr, int fq) const {
        const int row0 = u.pm * 256 + wr * 64 + fr, col0 = u.pn * 128 + wc * 32 + 8 * fq;
        float rsv[2][4];
#pragma unroll
        for (int ai = 0; ai < 2; ++ai)
#pragma unroll
            for (int m = 0; m < 4; ++m) rsv[ai][m] = rs[ui * 256 + wr * 64 + fr + ai * 128 + m * 16];
        asm volatile("" ::: "memory");
#pragma unroll
        for (int ai = 0; ai < 2; ++ai)
#pragma unroll
            for (int m = 0; m < 4; ++m) {
                const int r = row0 + ai * 128 + m * 16; const float rs = rsv[ai][m];
                const float rs2 = rs * rs, rsn = -1.4426950408889634f * rs;
                f32x4 h[2];
#pragma unroll
                for (int n = 0; n < 2; ++n) {
                    const f32x4 G = acc[ai][0][m][n], U = acc[ai][1][m][n];
                    const f32x4 pq = (G * U) * rs2, x = G * rsn;
                    f32x4 e;
#pragma unroll
                    for (int j = 0; j < 4; ++j) e[j] = __builtin_amdgcn_exp2f(x[j]);
                    const f32x4 dn = e + 1.0f;
                    f32x4 rc;
#pragma unroll
                    for (int j = 0; j < 4; ++j) rc[j] = __builtin_amdgcn_rcpf(dn[j]);
                    h[n] = pq * rc;
                }
                *(GAS u32x4*)(act + (size_t)r * DFF + col0) = pack8(h[0], h[1]);
            }
    }
};
struct EpiRes {
    GAS bf16_t* xb; GAS u64* ssq_out; float alpha;
    __device__ __forceinline__ void operator()(const AccT& acc, const pg8::Unit& u, int ui, int wr, int wc, int fr, int fq) const {
        const int row0 = u.pm * 256 + wr * 64 + fr, col0 = u.pn * 256 + wc * 32 + 8 * fq;
        u32x4 xv[2][4][2];
#pragma unroll
        for (int ai = 0; ai < 2; ++ai)
#pragma unroll
            for (int m = 0; m < 4; ++m)
#pragma unroll
                for (int bj = 0; bj < 2; ++bj) xv[ai][m][bj] = *(const GAS u32x4*)(xb + (size_t)(row0 + ai * 128 + m * 16) * DM + col0 + bj * 128);
        asm volatile("" ::: "memory");
#pragma unroll
        for (int ai = 0; ai < 2; ++ai) {
#pragma unroll
            for (int m = 0; m < 4; ++m) {
                const int r = row0 + ai * 128 + m * 16; float sq = 0.f;
#pragma unroll
                for (int bj = 0; bj < 2; ++bj) {
                    const size_t off = (size_t)r * DM + col0 + bj * 128;
                    f32x4 x0, x1; unpack8(xv[ai][m][bj], x0, x1);
                    const f32x4 y0 = x0 + alpha * acc[ai][bj][m][0], y1 = x1 + alpha * acc[ai][bj][m][1];
                    *(GAS u32x4*)(xb + off) = pack8(y0, y1);
                    sq += (y0[0] * y0[0] + y0[1] * y0[1]) + (y0[2] * y0[2] + y0[3] * y0[3]) + (y1[0] * y1[0] + y1[1] * y1[1]) + (y1[2] * y1[2] + y1[3] * y1[3]);
                }
                sq += __shfl_xor(sq, 16); sq += __shfl_xor(sq, 32);
                if (fq == 0) (void)__hip_atomic_fetch_add(ssq_out + r, ssq_fix(sq), __ATOMIC_RELAXED, __HIP_MEMORY_SCOPE_AGENT);
            }
        }
    }
};
template <int SECOND> struct EpiMrg {
    GAS bf16_t* y; const GAS bf16_t* gate;
    __device__ __forceinline__ void operator()(const AccT& acc, const pg8::Unit& u, int ui, int wr, int wc, int fr, int fq) const {
        const int row0 = u.pm * 256 + wr * 64 + fr, col0 = u.pn * 256 + wc * 32 + 8 * fq;
#pragma unroll
        for (int ai = 0; ai < 2; ++ai) {
            u32x4 gv[4][2], yv[4][2];
#pragma unroll
            for (int m = 0; m < 4; ++m)
#pragma unroll
                for (int bj = 0; bj < 2; ++bj) { const size_t off = (size_t)(row0 + ai * 128 + m * 16) * DM + col0 + bj * 128;
                    gv[m][bj] = *(const GAS u32x4*)(gate + off); if (SECOND) yv[m][bj] = *(const GAS u32x4*)(y + off); }
            asm volatile("" ::: "memory");
#pragma unroll
            for (int m = 0; m < 4; ++m)
#pragma unroll
                for (int bj = 0; bj < 2; ++bj) { const size_t off = (size_t)(row0 + ai * 128 + m * 16) * DM + col0 + bj * 128;
                    f32x4 g0, g1; unpack8(gv[m][bj], g0, g1);
                    f32x4 o0 = g0 * acc[ai][bj][m][0], o1 = g1 * acc[ai][bj][m][1];
                    if (SECOND) { f32x4 p0, p1; unpack8(yv[m][bj], p0, p1); o0 += p0; o1 += p1; }
                    *(GAS u32x4*)(y + off) = pack8(o0, o1); }
        }
    }
};
struct EpiIn {
    const LAS float* rs; GAS unsigned char* ws; const GAS float* tab;
    __device__ __forceinline__ void operator()(const AccT& acc, const pg8::Unit& u, int ui, int wr, int wc, int fr, int fq) const {
        const int pn = u.pn; const int row0 = u.pm * 256 + wr * 64 + fr;
        const GAS float* cosA = tab; const GAS float* sinA = tab + 65536; const GAS float* cosI = tab + 131072; const GAS float* sinI = tab + 163840;
        if (pn < 38) {
            GAS bf16_t* dst; int ld, cbase, rope = 0, act = 0;
            if (pn < 4)       { dst = (GAS bf16_t*)(ws + WS_AQ); ld = 1024; cbase = pn * 256; rope = 1; }
            else if (pn == 4) { dst = (GAS bf16_t*)(ws + WS_AK); ld = 256;  cbase = 0; rope = 1; }
            else if (pn == 5) { dst = (GAS bf16_t*)(ws + WS_AV); ld = 256;  cbase = 0; }
            else if (pn < 10) { dst = (GAS bf16_t*)(ws + WS_IQ); ld = 1024; cbase = (pn - 6) * 256; rope = 2; }
            else if (pn < 12) { dst = (GAS bf16_t*)(ws + WS_GQ); ld = 512;  cbase = (pn - 10) * 256; }
            else if (pn < 14) { dst = (GAS bf16_t*)(ws + WS_GK); ld = 512;  cbase = (pn - 12) * 256; }
            else if (pn < 18) { dst = (GAS bf16_t*)(ws + WS_GV); ld = 1024; cbase = (pn - 14) * 256; }
            else if (pn < 22) { dst = (GAS bf16_t*)(ws + WS_GR); ld = 1024; cbase = (pn - 18) * 256; act = 1; }
            else if (pn < 30) { dst = (GAS bf16_t*)(ws + WS_SA); ld = 2048; cbase = (pn - 22) * 256; act = 2; }
            else              { dst = (GAS bf16_t*)(ws + WS_SG); ld = 2048; cbase = (pn - 30) * 256; act = 2; }
            const bool ropeA = (rope == 1) && (wc == 0);
            const bool ropeI = (rope == 2) && ((wc & 1) == 0) && (fq < 2);
            float rsv[2][4];
#pragma unroll
            for (int ai = 0; ai < 2; ++ai)
#pragma unroll
                for (int m = 0; m < 4; ++m) rsv[ai][m] = rs[ui * 256 + wr * 64 + fr + ai * 128 + m * 16];
#pragma unroll
            for (int ai = 0; ai < 2; ++ai) {
                f32x4 csv[4], snv[4];
#pragma unroll
                for (int m = 0; m < 4; ++m) { const int t = (row0 + ai * 128 + m * 16) & (SEQ - 1);
                    csv[m] = (f32x4){1.f, 1.f, 1.f, 1.f}; snv[m] = (f32x4){0.f, 0.f, 0.f, 0.f};
                    if (ropeA) { csv[m] = *(const GAS f32x4*)(cosA + t * 16 + 4 * fq); snv[m] = *(const GAS f32x4*)(sinA + t * 16 + 4 * fq); }
                    if (ropeI) { csv[m] = *(const GAS f32x4*)(cosI + t * 8 + 4 * fq); snv[m] = *(const GAS f32x4*)(sinI + t * 8 + 4 * fq); } }
                asm volatile("" ::: "memory");
#pragma unroll
                for (int m = 0; m < 4; ++m) {
                    const int r = row0 + ai * 128 + m * 16; const float rs = rsv[ai][m];
                    const f32x4 cs = csv[m], sn = snv[m];
#pragma unroll
                    for (int bj = 0; bj < 2; ++bj) {
                        const f32x4 v0 = acc[ai][bj][m][0] * rs, v1 = acc[ai][bj][m][1] * rs;
                        f32x4 o0 = v0 * cs - v1 * sn, o1 = v1 * cs + v0 * sn;
                        if (act == 1) {
#pragma unroll
                            for (int j = 0; j < 4; ++j) { o0[j] = silu_f(o0[j]); o1[j] = silu_f(o1[j]); } }
                        if (act == 2) {
#pragma unroll
                            for (int j = 0; j < 4; ++j) { o0[j] = sigmoid_f(o0[j]); o1[j] = sigmoid_f(o1[j]); } }
                        *(GAS u32x4*)(dst + (size_t)r * ld + cbase + bj * 128 + wc * 32 + 8 * fq) = pack8(o0, o1);
                    }
                }
            }
        } else {
            if (wc == 3) return;
            const bool ropeI = (wc == 0) && (fq < 2);
#pragma unroll
            for (int ai = 0; ai < 2; ++ai)
#pragma unroll
                for (int m = 0; m < 4; ++m) {
                    const int r = row0 + ai * 128 + m * 16; const float rs = this->rs[ui * 256 + (r & 255)]; const int t = r & (SEQ - 1);
                    const f32x4 v0 = acc[ai][0][m][0] * rs, v1 = acc[ai][0][m][1] * rs;
                    if (wc < 2) {
                        f32x4 cs = (f32x4){1.f, 1.f, 1.f, 1.f}, sn = (f32x4){0.f, 0.f, 0.f, 0.f};
                        if (ropeI) { cs = *(const GAS f32x4*)(cosI + t * 8 + 4 * fq); sn = *(const GAS f32x4*)(sinI + t * 8 + 4 * fq); }
                        const f32x4 o0 = v0 * cs - v1 * sn, o1 = v1 * cs + v0 * sn;
                        *(GAS u32x4*)((GAS bf16_t*)(ws + WS_IK) + (size_t)r * 64 + wc * 32 + 8 * fq) = pack8(o0, o1);
                    } else {
                        if (fq < 2) { GAS float* p = (GAS float*)(ws + WS_IW) + (size_t)r * 16 + 8 * fq; *(GAS f32x4*)p = v0 * 0.03125f; *(GAS f32x4*)(p + 4) = v1 * 0.03125f; }
                        else        { GAS float* p = (GAS float*)(ws + WS_GA) + (size_t)r * 16 + 8 * (fq - 2); *(GAS f32x4*)p = v0; *(GAS f32x4*)(p + 4) = v1; }
                    }
                }
        }
    }
};

__device__ __forceinline__ int perm128(int hc) { return hc < 32 ? (16 * ((hc >> 2) & 1) + 4 * (hc >> 3) + (hc & 3)) : hc; }
__device__ __forceinline__ int perm64(int hc) { return hc < 16 ? (8 * ((hc >> 2) & 1) + 4 * (hc >> 3) + (hc & 3)) : hc; }
__device__ __forceinline__ int src_in(int p) {
    const int tile = p >> 8, w = p & 255;
    if (tile < 4)  return OFF_AQ + (2 * tile + (w >> 7)) * 128 + perm128(w & 127);
    if (tile == 4) return OFF_AK + (w >> 7) * 128 + perm128(w & 127);
    if (tile == 5) return OFF_AV + w;
    if (tile < 10) return OFF_IQ + (4 * (tile - 6) + (w >> 6)) * 64 + perm64(w & 63);
    if (tile < 12) return OFF_GQ + (tile - 10) * 256 + w;
    if (tile < 14) return OFF_GK + (tile - 12) * 256 + w;
    if (tile < 18) return OFF_GV + (tile - 14) * 256 + w;
    if (tile < 22) return OFF_GR + (tile - 18) * 256 + w;
    if (tile < 30) return OFF_MA + (tile - 22) * 256 + w;
    if (tile < 38) return OFF_MG + (tile - 30) * 256 + w;
    if (w < 64) return OFF_IK + perm64(w);
    if (w < 80) return OFF_IW + (w - 64);
    if (w < 96) return OFF_GA + (w - 80);
    return -1;
}
template <int KIND>
__device__ __forceinline__ void conv_load(f32x4 (&v)[8], const GAS float* W0, const GAS float* W1, int N, int nblk, int item, int lane) {
    const int kb = item / nblk, nb = item % nblk, k0 = 64 * kb, p0 = 32 * nb;
    const int n4 = lane & 7, p = p0 + 4 * n4;
    const GAS float* src = W0; int c = p;
    if (KIND == 1) { const int tile = p >> 8, w = p & 255; src = (w < 128) ? W0 : W1; c = tile * 128 + (w & 127); }
    if (KIND == 2) c = src_in(p);
#pragma unroll
    for (int i = 0; i < 8; ++i) { const int kk = 8 * i + (lane >> 3);
        v[i] = (f32x4){0.f, 0.f, 0.f, 0.f};
        if (c >= 0) v[i] = *(const GAS f32x4*)(src + (size_t)(k0 + kk) * N + c); }
}
template <int KIND>
__device__ __forceinline__ void conv_job(const GAS float* W0, const GAS float* W1, const GAS float* gain, GAS bf16_t* dst, int K, int N, int nrows, LAS float* scr, int gw, int NGW, int lane) {
    const int nblk = nrows / 32, items = (K / 64) * nblk;
    f32x4 cur[8], nxt[8];
    if (gw < items) conv_load<KIND>(cur, W0, W1, N, nblk, gw, lane);
    for (int item = gw; item < items; item += NGW) {
        const int kb = item / nblk, nb = item % nblk, k0 = 64 * kb, p0 = 32 * nb; const int n4 = lane & 7;
        if (item + NGW < items) conv_load<KIND>(nxt, W0, W1, N, nblk, item + NGW, lane);
#pragma unroll
        for (int i = 0; i < 8; ++i) { const int kk = 8 * i + (lane >> 3);
            f32x4 v = cur[i];
            if (gain) v *= gain[k0 + kk];
            LAS float* d = scr + kk * 33 + 4 * n4; d[0] = v[0]; d[1] = v[1]; d[2] = v[2]; d[3] = v[3]; }
        LDS_WAIT(); asm volatile("" ::: "memory");
        const int c8 = lane & 7;
#pragma unroll
        for (int j = 0; j < 4; ++j) { const int n = (lane >> 3) + 8 * j; const LAS float* s = scr + (8 * c8) * 33 + n;
            u32x4 o; o.x = cvt_pk_bf16(s[0 * 33], s[1 * 33]); o.y = cvt_pk_bf16(s[2 * 33], s[3 * 33]); o.z = cvt_pk_bf16(s[4 * 33], s[5 * 33]); o.w = cvt_pk_bf16(s[6 * 33], s[7 * 33]);
            *(GAS u32x4*)(dst + ((((size_t)(p0 >> 8) * (K >> 6) + (k0 >> 6)) * 256 + ((p0 + n) & 255)) << 6) + 8 * c8) = o; }
        LDS_WAIT(); asm volatile("" ::: "memory");
#pragma unroll
        for (int i = 0; i < 8; ++i) cur[i] = nxt[i];
    }
}

__device__ __forceinline__ int slot_base(int lane) { return 32 * (lane >> 3) + 8 * ((lane >> 1) & 3) + (lane & 1); }
__device__ __forceinline__ int wave_sum_i32(int x) {
    x += __builtin_amdgcn_update_dpp(0, x, 0xB1, 0xF, 0xF, true);
    x += __builtin_amdgcn_update_dpp(0, x, 0x4E, 0xF, 0xF, true);
    x += __builtin_amdgcn_update_dpp(0, x, 0x141, 0xF, 0xF, true);
    x += __builtin_amdgcn_update_dpp(0, x, 0x140, 0xF, 0xF, true);
    x += __builtin_amdgcn_update_dpp(0, x, 0x142, 0xA, 0xF, true);
    x += __builtin_amdgcn_update_dpp(0, x, 0x143, 0xC, 0xF, true);
    return __builtin_amdgcn_readlane(x, 63);
}
__device__ __forceinline__ void select_topk(int t, const GAS float* row, LAS unsigned* M32, int qbit, int lane) {
    unsigned T[64];
    int l4 = 4 * lane; asm volatile("" : "+v"(l4));
#pragma unroll
    for (int jj = 0; jj < 16; ++jj) {
        const f32x4 v = *(const GAS f32x4*)(row + 256 * jj + 4 * lane);
#pragma unroll
        for (int c = 0; c < 4; ++c) { const float fv = v[c]; const unsigned b = __builtin_bit_cast(unsigned, fv);
            const unsigned o = b ^ ((unsigned)((int)b >> 31) | 0x80000000u); T[4 * jj + c] = (l4 <= t - (256 * jj + c)) ? o : 0u; }
    }
#define TSTAGE(j, m) _Pragma("unroll") for (int hb = 0; hb < 64; hb += 32) _Pragma("unroll") for (int k = 0; k < 32; k = (k + (j) + 1) & ~(j)) { \
        const unsigned a_ = T[hb + k], b_ = T[hb + k + (j)]; T[hb + k] = (a_ & (m)) | ((b_ << (j)) & ~(m)); T[hb + k + (j)] = ((a_ >> (j)) & (m)) | (b_ & ~(m)); }
    TSTAGE(16, 0x0000FFFFu) TSTAGE(8, 0x00FF00FFu) TSTAGE(4, 0x0F0F0F0Fu) TSTAGE(2, 0x33333333u) TSTAGE(1, 0x55555555u)
#undef TSTAGE
    unsigned al0 = 0xFFFFFFFFu, al1 = 0xFFFFFFFFu, gt0 = 0u, gt1 = 0u; int k = 256; bool exact = false;
#pragma unroll
    for (int bit = 31; bit >= 0; --bit) {
        const unsigned m0 = al0 & T[bit], m1 = al1 & T[32 + bit];
        const int C = wave_sum_i32(__popc(m0) + __popc(m1));
        if (C >= k) { al0 = m0; al1 = m1; if (C == k) { exact = true; break; } }
        else { k -= C; gt0 |= m0; gt1 |= m1; al0 &= ~T[bit]; al1 &= ~T[32 + bit]; }
    }
    LAS unsigned* mp = M32 + (lane >> 4) * 64 + (lane & 1) * 32 + qbit; const int sh = 16 * ((lane >> 3) & 1) + 4 * ((lane >> 1) & 3);
    if (exact) {
        const unsigned s0 = gt0 | al0, s1 = gt1 | al1;
#pragma unroll
        for (int jj = 0; jj < 16; ++jj) { const unsigned nib = ((jj < 8 ? s0 : s1) >> (4 * (jj & 7))) & 15u;
            if (nib) (void)__hip_atomic_fetch_or(mp + 256 * jj, nib << sh, __ATOMIC_RELAXED, __HIP_MEMORY_SCOPE_WORKGROUP); }
    } else {
        int eqused = 0;
        const unsigned long long lt = (1ull << lane) - 1ull;
#pragma unroll
        for (int e = 0; e < 64; ++e) {
            const bool gt = ((e < 32 ? gt0 : gt1) >> (e & 31)) & 1u, eq = ((e < 32 ? al0 : al1) >> (e & 31)) & 1u;
            const unsigned long long eqb = __ballot(eq);
            const bool take = gt || (eq && (eqused + __popcll(eqb & lt)) < k);
            if (take) (void)__hip_atomic_fetch_or(mp + 256 * (e >> 2), 1u << (sh + (e & 3)), __ATOMIC_RELAXED, __HIP_MEMORY_SCOPE_WORKGROUP);
            eqused += __popcll(eqb);
        }
    }
}
__device__ __forceinline__ void select_all(int t, LAS unsigned* M32, int qbit, int lane) {
    LAS unsigned* mp = M32 + (lane >> 4) * 64 + (lane & 1) * 32 + qbit; const int sh = 16 * ((lane >> 3) & 1) + 4 * ((lane >> 1) & 3);
    unsigned nib = 0u;
#pragma unroll
    for (int c = 0; c < 4; ++c) if (4 * lane + c <= t) nib |= 1u << c;
    if (nib) (void)__hip_atomic_fetch_or(mp, nib << sh, __ATOMIC_RELAXED, __HIP_MEMORY_SCOPE_WORKGROUP);
}

__device__ __forceinline__ void idx_phase(LAS unsigned char* lds, const GAS bf16_t* iq, const GAS bf16_t* ik, const GAS float* iw, GAS float* scr, GAS unsigned* maskT,
                                          int G, int tid, int lane, int wave) {
    GAS float* myscr = scr + (size_t)(blockIdx.x * 8 + wave) * 8192;
    LAS unsigned* M32 = (LAS unsigned*)(lds + 32768);
    const int rho = lane & 31, qsel = (rho >> 2) & 1, head = (rho & 3) + 4 * (rho >> 3), kh = lane >> 5;
    for (int pr = blockIdx.x; pr < 256; pr += G) {
        const int b = pr >> 6, q = pr & 63; const size_t rb = (size_t)b * SEQ;
#pragma unroll 1
        for (int it = 0; it < 2; ++it) {
            const int blk = it ? 127 - q : q;
#pragma unroll
            for (int i = 0; i < 2; ++i) *(LAS u32x4*)(M32 + 4 * (tid + 512 * i)) = (u32x4){0u, 0u, 0u, 0u};
            __syncthreads();
#pragma unroll 1
            for (int half = 0; half < 2; ++half) {
                const int tb = 32 * blk + 16 * half, t0 = tb + 2 * wave;
                if (tb + 15 < 256) {
                    select_all(t0, M32, 16 * half + 2 * wave, lane); select_all(t0 + 1, M32, 16 * half + 2 * wave + 1, lane);
                    continue;
                }
                const GAS bf16_t* ap = iq + (rb + t0 + qsel) * 1024 + head * 64 + kh * 8;
                bf16x8 A[4];
#pragma unroll
                for (int ks = 0; ks < 4; ++ks) A[ks] = *(const GAS bf16x8*)(ap + ks * 16);
                float w[16];
                { const GAS f32x4* wp = (const GAS f32x4*)(iw + (rb + t0 + kh) * 16);
#pragma unroll
                  for (int i = 0; i < 4; ++i) { const f32x4 x = wp[i]; w[4 * i] = x[0]; w[4 * i + 1] = x[1]; w[4 * i + 2] = x[2]; w[4 * i + 3] = x[3]; } }
                const int ng = ((tb + 15) >> 7) + 1;
                const GAS bf16_t* kg = ik + rb * 64;
                u32x4 st0, st1;
                { const int c0 = tid, c1 = tid + 512; st0 = *(const GAS u32x4*)(kg + (size_t)(c0 >> 3) * 64 + (c0 & 7) * 8); st1 = *(const GAS u32x4*)(kg + (size_t)(c1 >> 3) * 64 + (c1 & 7) * 8); }
                { const int c0 = tid, c1 = tid + 512; const int k0 = c0 >> 3, k1 = c1 >> 3;
                  *(LAS u32x4*)(lds + k0 * 128 + (((c0 & 7) ^ ((k0 >> 1) & 7)) << 4)) = st0; *(LAS u32x4*)(lds + k1 * 128 + (((c1 & 7) ^ ((k1 >> 1) & 7)) << 4)) = st1; }
                __syncthreads();
                GAS float* srow = myscr + kh * 4096 + (lane & 31);
                f32x16 zero16;
#pragma unroll
                for (int i = 0; i < 16; ++i) zero16[i] = 0.f;
                asm volatile("" : "+v"(zero16));
                asm volatile("" :: "v"(A[0]), "v"(A[1]), "v"(A[2]), "v"(A[3]), "v"(w[0]), "v"(w[1]), "v"(w[2]), "v"(w[3]), "v"(w[4]), "v"(w[5]), "v"(w[6]), "v"(w[7]),
                             "v"(w[8]), "v"(w[9]), "v"(w[10]), "v"(w[11]), "v"(w[12]), "v"(w[13]), "v"(w[14]), "v"(w[15]));
#pragma unroll 1
                for (int g = 0; g < ng; ++g) {
                    LAS unsigned char* buf = lds + (g & 1) * 16384;
                    if (g + 1 < ng) { const GAS bf16_t* kn = kg + (size_t)(g + 1) * 128 * 64; const int c0 = tid, c1 = tid + 512;
                        st0 = *(const GAS u32x4*)(kn + (size_t)(c0 >> 3) * 64 + (c0 & 7) * 8); st1 = *(const GAS u32x4*)(kn + (size_t)(c1 >> 3) * 64 + (c1 & 7) * 8); }
                    float scv[4];
#pragma unroll
                    for (int jj = 0; jj < 4; ++jj) {
                        const int key = jj * 32 + (lane & 31);
                        f32x16 c;
#pragma unroll
                        for (int ks = 0; ks < 4; ++ks) { const bf16x8 Bf = *(const LAS bf16x8*)(buf + key * 128 + (((ks * 2 + kh) ^ ((key >> 1) & 7)) << 4));
                            c = __builtin_amdgcn_mfma_f32_32x32x16_bf16(A[ks], Bf, ks == 0 ? zero16 : c, 0, 0, 0); }
                        f32x2 acc2 = (f32x2){0.f, 0.f};
#pragma unroll
                        for (int i = 0; i < 16; i += 2) { const float c0 = c[i], c1 = c[i + 1]; const int b0 = __builtin_bit_cast(int, c0), b1 = __builtin_bit_cast(int, c1);
                            const f32x2 rr = (f32x2){__builtin_bit_cast(float, b0 > 0 ? b0 : 0), __builtin_bit_cast(float, b1 > 0 ? b1 : 0)};
                            acc2 += (f32x2){w[i], w[i + 1]} * rr; }
                        float sc = acc2[0] + acc2[1];
                        asm volatile("" : "+v"(sc));
                        scv[jj] = sc;
                    }
                    if (g + 1 < ng) { LAS unsigned char* nb = lds + ((g + 1) & 1) * 16384; const int c0 = tid, c1 = tid + 512; const int k0 = c0 >> 3, k1 = c1 >> 3;
                        *(LAS u32x4*)(nb + k0 * 128 + (((c0 & 7) ^ ((k0 >> 1) & 7)) << 4)) = st0; *(LAS u32x4*)(nb + k1 * 128 + (((c1 & 7) ^ ((k1 >> 1) & 7)) << 4)) = st1; }
                    asm volatile("" ::: "memory");
#pragma unroll
                    for (int jj = 0; jj < 4; ++jj) srow[(g * 4 + jj) * 32] = scv[jj];
                    LDS_WAIT(); asm volatile("" ::: "memory"); __builtin_amdgcn_s_barrier(); asm volatile("" ::: "memory");
                }
                VM_WAIT();
                __builtin_amdgcn_fence(__ATOMIC_ACQUIRE, "agent");
                VM_WAIT();
#pragma unroll 1
                for (int qi = 0; qi < 2; ++qi) select_topk(t0 + qi, myscr + qi * 4096, M32, 16 * half + 2 * wave + qi, lane);
            }
            LDS_WAIT();
            __syncthreads();
            { GAS unsigned* mo = maskT + ((size_t)b * 128 + blk) * 4096;
#pragma unroll
              for (int i = 0; i < 2; ++i) *(GAS u32x4*)(mo + 4 * (tid + 512 * i)) = *(const LAS u32x4*)(M32 + 4 * (tid + 512 * i)); }
            __syncthreads();
        }
    }
}
__device__ __forceinline__ void vt_phase(LAS unsigned char* lds, const GAS bf16_t* av, GAS bf16_t* vT, int G, int tid) {
    LAS bf16_t* T = (LAS bf16_t*)lds;
    for (int unit = blockIdx.x; unit < 512; unit += G) {
        const int b = unit >> 7, g = (unit >> 6) & 1, kt = unit & 63;
#pragma unroll
        for (int i = 0; i < 2; ++i) { const int c = tid + 512 * i, key = c >> 4, ch = c & 15;
            *(LAS u32x4*)(T + key * 136 + 8 * ch) = *(const GAS u32x4*)(av + ((size_t)b * SEQ + 64 * kt + key) * 256 + g * 128 + 8 * ch); }
        __syncthreads();
#pragma unroll
        for (int i = 0; i < 2; ++i) { const int c = tid + 512 * i, d = c & 127, k8 = c >> 7;
            unsigned v[8];
#pragma unroll
            for (int jj = 0; jj < 8; ++jj) v[jj] = T[(8 * k8 + jj) * 136 + d];
            *(GAS u32x4*)(vT + (((size_t)b * 2 + g) * 128 + d) * SEQ + 64 * kt + 8 * k8) = (u32x4){v[0] | (v[1] << 16), v[2] | (v[3] << 16), v[4] | (v[5] << 16), v[6] | (v[7] << 16)}; }
        LDS_WAIT(); asm volatile("" ::: "memory"); __builtin_amdgcn_s_barrier(); asm volatile("" ::: "memory");
    }
}

__device__ __forceinline__ float logsig_f(float x) { return fminf(x, 0.f) - __logf(1.f + __expf(-fabsf(x))); }
__device__ __forceinline__ void gla_a_phase(LAS unsigned char* lds, const GAS bf16_t* gq, const GAS bf16_t* gk, const GAS bf16_t* gv, const GAS float* ga, const GAS float* wa2, const GAS float* ba,
                                            GAS bf16_t* QBg, GAS bf16_t* KDTg, GAS bf16_t* VTg, GAS bf16_t* ATFg, GAS float* DECg, int G, int tid, int lane, int wave) {
    LAS bf16_t* QE = (LAS bf16_t*)(lds);
    LAS bf16_t* KD = (LAS bf16_t*)(lds + 17408);
    LAS bf16_t* VS = (LAS bf16_t*)(lds + 34816);
    LAS float* GAL = (LAS float*)(lds + 68608);
    LAS float* GSUM = (LAS float*)(lds + 72704);
    const int d = tid & 127, tg = tid >> 7;
    const float SC = 0.08838834764831845f;
    for (int unit = blockIdx.x; unit < 1024; unit += G) {
        const int b = unit >> 8, h = (unit >> 6) & 3, n = unit & 63;
        const size_t R0 = (size_t)b * SEQ + 64 * n;
        float wa[16];
#pragma unroll
        for (int r = 0; r < 16; ++r) wa[r] = wa2[r * 512 + h * 128 + d];
        const float bias = ba[h * 128 + d];
        if (tid < 256) *(LAS f32x4*)(GAL + 4 * tid) = *(const GAS f32x4*)(ga + R0 * 16 + 4 * tid);
#pragma unroll
        for (int k = 0; k < 4; ++k) { const int idx = tid + 512 * k, row = idx >> 5, c16 = idx & 31;
            *(LAS u32x4*)(VS + row * 264 + 8 * c16) = *(const GAS u32x4*)(gv + (R0 + row) * 1024 + h * 256 + 8 * c16); }
        float qv[16], kv[16];
#pragma unroll
        for (int i = 0; i < 16; ++i) { const size_t o = (R0 + 16 * tg + i) * 512 + h * 128 + d; qv[i] = bf2f(gq[o]); kv[i] = bf2f(gk[o]); }
        __syncthreads();
        float cs[16], run = 0.f;
#pragma unroll
        for (int i = 0; i < 16; ++i) { const LAS f32x4* gp = (const LAS f32x4*)(GAL + (16 * tg + i) * 16);
            const f32x4 g0 = gp[0], g1 = gp[1], g2 = gp[2], g3 = gp[3];
            float x = bias;
            x += g0[0] * wa[0] + g0[1] * wa[1] + g0[2] * wa[2] + g0[3] * wa[3];
            x += g1[0] * wa[4] + g1[1] * wa[5] + g1[2] * wa[6] + g1[3] * wa[7];
            x += g2[0] * wa[8] + g2[1] * wa[9] + g2[2] * wa[10] + g2[3] * wa[11];
            x += g3[0] * wa[12] + g3[1] * wa[13] + g3[2] * wa[14] + g3[3] * wa[15];
            run += logsig_f(x) * 0.0625f; cs[i] = run; }
        GSUM[tg * 128 + d] = run;
        __syncthreads();
        const float s0 = GSUM[d], s1 = GSUM[128 + d], s2 = GSUM[256 + d], s3 = GSUM[384 + d];
        const float off = (tg > 0 ? s0 : 0.f) + (tg > 1 ? s1 : 0.f) + (tg > 2 ? s2 : 0.f), total = (s0 + s1) + (s2 + s3);
        unsigned kdp[8];
#pragma unroll
        for (int i = 0; i < 16; ++i) { const int tok = 16 * tg + i; const float bi = cs[i] + off; const float qs = qv[i] * SC;
            const unsigned qe = f2bf(qs * __expf(bi - total)), qb = f2bf(qs * __expf(bi)), kd = f2bf(kv[i] * __expf(total - bi));
            QE[tok * 136 + d] = (bf16_t)qe; KD[tok * 136 + d] = (bf16_t)kd;
            QBg[(R0 + tok) * 512 + h * 128 + d] = (bf16_t)qb;
            if (i & 1) kdp[i >> 1] |= kd << 16; else kdp[i >> 1] = kd; }
        { GAS bf16_t* kp = KDTg + (size_t)unit * 8192 + d * 64 + 16 * tg;
          *(GAS u32x4*)kp = (u32x4){kdp[0], kdp[1], kdp[2], kdp[3]}; *(GAS u32x4*)(kp + 8) = (u32x4){kdp[4], kdp[5], kdp[6], kdp[7]}; }
        if (tg == 0) DECg[(size_t)unit * 128 + d] = __expf(total);
#pragma unroll
        for (int k = 0; k < 4; ++k) { const int idx = tid + 512 * k, e = idx & 255, jg = idx >> 8;
            unsigned v[8];
#pragma unroll
            for (int jj = 0; jj < 8; ++jj) v[jj] = VS[(8 * jg + jj) * 264 + e];
            *(GAS u32x4*)(VTg + (size_t)unit * 16384 + e * 64 + 8 * jg) = (u32x4){v[0] | (v[1] << 16), v[2] | (v[3] << 16), v[4] | (v[5] << 16), v[6] | (v[7] << 16)}; }
        LDS_WAIT(); asm volatile("" ::: "memory"); __builtin_amdgcn_s_barrier(); asm volatile("" ::: "memory");
#pragma unroll
        for (int tt = 0; tt < 2; ++tt) {
            const int idx = 2 * wave + tt, jt = idx >> 2, it = idx & 3; const int l15 = lane & 15, q4 = lane >> 4;
            f32x4 c = (f32x4){0.f, 0.f, 0.f, 0.f};
            asm volatile("" : "+v"(c));
            if (jt <= it) {
#pragma unroll
                for (int ks = 0; ks < 4; ++ks) {
                    const bf16x8 a = *(const LAS bf16x8*)(KD + (16 * jt + l15) * 136 + ks * 32 + 8 * q4);
                    const bf16x8 bb = *(const LAS bf16x8*)(QE + (16 * it + l15) * 136 + ks * 32 + 8 * q4);
                    c = __builtin_amdgcn_mfma_f32_16x16x32_bf16(a, bb, c, 0, 0, 0);
                }
#pragma unroll
                for (int r = 0; r < 4; ++r) { const int j = 16 * jt + 4 * q4 + r, i = 16 * it + l15; if (j > i) c[r] = 0.f; }
            }
            asm volatile("s_nop 7\n\ts_nop 7" : "+v"(c));
            u32x2 o; o.x = cvt_pk_bf16(c[0], c[1]); o.y = cvt_pk_bf16(c[2], c[3]);
            *(GAS u32x2*)(ATFg + (size_t)unit * 4096 + ((it * 2 + (jt >> 1)) * 64 + lane) * 8 + 4 * (jt & 1)) = o;
        }
        LDS_WAIT(); asm volatile("" ::: "memory"); __builtin_amdgcn_s_barrier(); asm volatile("" ::: "memory");
    }
}

__device__ __forceinline__ bf16x8 mk8(u32x2 lo, u32x2 hi) { u32x4 w = (u32x4){lo.x, lo.y, hi.x, hi.y}; return __builtin_bit_cast(bf16x8, w); }
constexpr int GB_KDT = 0, GB_QB = 18432, GB_ATF = 35840, GB_VT = 44032, GB_DEC = 46336, GB_BUF = 46848, GB_X = 2 * GB_BUF;
struct GlaStage { u32x4 v[6]; };
struct GlaSrc { const GAS char* kd; const GAS char* qb; const GAS char* at; const GAS char* vt; const GAS char* dc; unsigned okd, oqb, oat, ovd; bool isdec; };
__device__ __forceinline__ void gla_b_ldg(GlaStage& st, const GlaSrc& g, int n) {
    const GAS char* kd = g.kd + (size_t)n * 16384; const GAS char* qb = g.qb + (size_t)n * 65536; const GAS char* at = g.at + (size_t)n * 8192;
    const GAS char* vd = g.isdec ? g.dc + (size_t)n * 512 : g.vt + (size_t)n * 32768;
    const GAS char* kd2 = kd + 8192; const GAS char* qb2 = qb + 32768;
    asm volatile("s_nop 4\n\tglobal_load_dwordx4 %0, %6, %10\n\tglobal_load_dwordx4 %1, %6, %11\n\tglobal_load_dwordx4 %2, %7, %12\n\tglobal_load_dwordx4 %3, %7, %13\n\t"
                 "global_load_dwordx4 %4, %8, %14\n\tglobal_load_dwordx4 %5, %9, %15"
                 : "=&v"(st.v[0]), "=&v"(st.v[1]), "=&v"(st.v[2]), "=&v"(st.v[3]), "=&v"(st.v[4]), "=&v"(st.v[5])
                 : "v"(g.okd), "v"(g.oqb), "v"(g.oat), "v"(g.ovd), "s"(kd), "s"(kd2), "s"(qb), "s"(qb2), "s"(at), "s"(vd) : "memory");
}
template <int N> __device__ __forceinline__ void gla_b_wait(GlaStage& st) {
    asm volatile("s_waitcnt vmcnt(%6)" : "+v"(st.v[0]), "+v"(st.v[1]), "+v"(st.v[2]), "+v"(st.v[3]), "+v"(st.v[4]), "+v"(st.v[5]) : "i"(N) : "memory");
}
__device__ __forceinline__ void gla_b_sts(const GlaStage& st, LAS unsigned char* buf, int tid) {
    const int kr = tid >> 3, kc = tid & 7, qr = tid >> 4, qc = tid & 15;
    *(LAS u32x4*)(buf + GB_KDT + kr * 144 + kc * 16) = st.v[0]; *(LAS u32x4*)(buf + GB_KDT + (64 + kr) * 144 + kc * 16) = st.v[1];
    *(LAS u32x4*)(buf + GB_QB + qr * 272 + qc * 16) = st.v[2];  *(LAS u32x4*)(buf + GB_QB + (32 + qr) * 272 + qc * 16) = st.v[3];
    *(LAS u32x4*)(buf + GB_ATF + 16 * tid) = st.v[4];
    if (tid < 128) *(LAS u32x4*)(buf + GB_VT + kr * 144 + kc * 16) = st.v[5];
    else if (tid < 160) *(LAS u32x4*)(buf + GB_DEC + 16 * (tid - 128)) = st.v[5];
}
__device__ __forceinline__ void gla_b_unit(int unit, int w, LAS unsigned char* lds, const GAS bf16_t* QBg, const GAS bf16_t* KDTg, const GAS bf16_t* VTg, const GAS bf16_t* ATFg, const GAS float* DECg, GAS float* ograw, int lane_) {
    int lane = lane_; asm volatile("" : "+v"(lane));
    const int tid = w * 64 + lane;
    const int b = unit >> 6, h = (unit >> 4) & 3, c = unit & 15, bh = b * 4 + h;
    const int l15 = lane & 15, q4 = lane >> 4; const f32x4 z = (f32x4){0.f, 0.f, 0.f, 0.f};
    f32x4 S[2] = {z, z};
    GlaStage r1, r2;
    VM_WAIT();
    GlaSrc gs;
    { const size_t cu0 = (size_t)bh * 64; const size_t R00 = (size_t)b * SEQ;
      gs.kd = (const GAS char*)(KDTg + cu0 * 8192); gs.qb = (const GAS char*)(QBg + R00 * 512 + h * 128); gs.at = (const GAS char*)(ATFg + cu0 * 4096);
      gs.vt = (const GAS char*)(VTg + cu0 * 16384 + 16 * c * 64); gs.dc = (const GAS char*)(DECg + cu0 * 128);
      gs.okd = 16u * tid; gs.oqb = (unsigned)((tid >> 4) * 1024 + 16 * (tid & 15)); gs.oat = 16u * tid;
      gs.isdec = (w >= 2);
      gs.ovd = (w < 2) ? 16u * tid : 16u * ((tid - 128) & 31); }
    gla_b_ldg(r2, gs, 0); gla_b_wait<0>(r2); gla_b_sts(r2, lds, tid);
    gla_b_ldg(r1, gs, 1);
    LDS_WAIT();
    __syncthreads();
#pragma unroll 1
    for (int n0 = 0; n0 < 64; n0 += 2) {
#pragma unroll
        for (int hh = 0; hh < 2; ++hh) {
            const int n = n0 + hh;
            GlaStage& cur = hh ? r2 : r1;
            GlaStage& nxt = hh ? r1 : r2;
            LAS unsigned char* buf = lds + hh * GB_BUF; LAS f32x4* Xp = (LAS f32x4*)(lds + GB_X + hh * 16384);
            f32x4 o = z;
            gla_b_ldg(nxt, gs, n + 2 < 64 ? n + 2 : 63);
            __builtin_amdgcn_sched_barrier(0);
            if (w < 4) {
                const LAS unsigned char* qbp = buf + GB_QB + l15 * 272 + (32 * w + 4 * q4) * 2;
                const LAS unsigned char* vtp = buf + GB_VT + l15 * 144;
                bf16x8 Aq[4], Apm[2], Bv[2], Ak[2][2]; f32x4 dec[2];
#pragma unroll
                for (int it = 0; it < 4; ++it) Aq[it] = mk8(*(const LAS u32x2*)(qbp + it * 16 * 272), *(const LAS u32x2*)(qbp + it * 16 * 272 + 32));
#pragma unroll
                for (int s2 = 0; s2 < 2; ++s2) { Apm[s2] = *(const LAS bf16x8*)(buf + GB_ATF + ((w * 2 + s2) * 64 + lane) * 16);
                    Bv[s2] = mk8(*(const LAS u32x2*)(vtp + (32 * s2 + 4 * q4) * 2), *(const LAS u32x2*)(vtp + (32 * s2 + 16 + 4 * q4) * 2)); }
                const bf16x8 Bsv0 = *(const LAS bf16x8*)(vtp + (8 * q4) * 2), Bsv1 = *(const LAS bf16x8*)(vtp + (32 + 8 * q4) * 2);
#pragma unroll
                for (int k = 0; k < 2; ++k) { const LAS unsigned char* kp = buf + GB_KDT + (32 * w + 16 * k + l15) * 144 + (8 * q4) * 2;
                    Ak[k][0] = *(const LAS bf16x8*)kp; Ak[k][1] = *(const LAS bf16x8*)(kp + 64);
                    dec[k] = *(const LAS f32x4*)(buf + GB_DEC + (32 * w + 16 * k + 4 * q4) * 4); }
                u32x4 wv; wv.x = cvt_pk_bf16(S[0][0], S[0][1]); wv.y = cvt_pk_bf16(S[0][2], S[0][3]); wv.z = cvt_pk_bf16(S[1][0], S[1][1]); wv.w = cvt_pk_bf16(S[1][2], S[1][3]);
                const bf16x8 Bs = __builtin_bit_cast(bf16x8, wv);
#pragma unroll
                for (int it = 0; it < 4; ++it) {
                    f32x4 zz = z; asm volatile("" : "+v"(zz));
                    zz = __builtin_amdgcn_mfma_f32_16x16x32_bf16(Aq[it], Bs, zz, 0, 0, 0); asm volatile("" : "+v"(zz) : "v"(Aq[it]));
                    if (it == w) o = zz; else Xp[(w * 4 + it) * 64 + lane] = zz; }
                asm volatile("" :: "v"(Bs));
#pragma unroll
                for (int s2 = 0; s2 < 2; ++s2) { o = __builtin_amdgcn_mfma_f32_16x16x32_bf16(Apm[s2], Bv[s2], o, 0, 0, 0); asm volatile("" : "+v"(o) : "v"(Apm[s2]), "v"(Bv[s2])); }
                { f32x4 t0 = S[0] * dec[0], t1 = S[1] * dec[1];
                  asm volatile("" : "+v"(t0), "+v"(t1));
                  t0 = __builtin_amdgcn_mfma_f32_16x16x32_bf16(Ak[0][0], Bsv0, t0, 0, 0, 0); asm volatile("" : "+v"(t0) : "v"(Ak[0][0]), "v"(Bsv0));
                  t1 = __builtin_amdgcn_mfma_f32_16x16x32_bf16(Ak[1][0], Bsv0, t1, 0, 0, 0); asm volatile("" : "+v"(t1) : "v"(Ak[1][0]), "v"(Bsv0));
                  t0 = __builtin_amdgcn_mfma_f32_16x16x32_bf16(Ak[0][1], Bsv1, t0, 0, 0, 0); asm volatile("" : "+v"(t0) : "v"(Ak[0][1]), "v"(Bsv1));
                  t1 = __builtin_amdgcn_mfma_f32_16x16x32_bf16(Ak[1][1], Bsv1, t1, 0, 0, 0); asm volatile("" : "+v"(t1) : "v"(Ak[1][1]), "v"(Bsv1));
                  S[0] = t0; S[1] = t1; }
            }
            gla_b_wait<6>(cur);
            if (n + 1 < 64) {
                gla_b_sts(cur, lds + (1 - hh) * GB_BUF, tid); }
            LDS_WAIT();
            asm volatile("" ::: "memory"); __builtin_amdgcn_s_barrier(); asm volatile("" ::: "memory");
            if (w < 4) {
#pragma unroll
                for (int ww = 0; ww < 4; ++ww) if (ww != w) o += Xp[(ww * 4 + w) * 64 + lane];
                const size_t R0 = (size_t)b * SEQ + 64 * n;
#pragma unroll
                for (int r = 0; r < 4; ++r) ograw[(R0 + 16 * w + 4 * q4 + r) * 1024 + h * 256 + 16 * c + l15] = o[r];
            }
        }
    }
    gla_b_wait<0>(r1); gla_b_wait<0>(r2);
}

__device__ __forceinline__ void ad_ldk(u32x4& a, u32x4& b, const GAS char* kt, unsigned koff) {
    const GAS char* kt2 = kt + 32 * 256 * 2;
    asm volatile("s_nop 4\n\tglobal_load_dwordx4 %0, %2, %3\n\tglobal_load_dwordx4 %1, %2, %4" : "=&v"(a), "=&v"(b) : "v"(koff), "s"(kt), "s"(kt2) : "memory");
}
__device__ __forceinline__ void ad_ldvm(u32x4& a, u32x4& b, unsigned& m, const GAS char* vt, unsigned voff, const GAS char* mp, unsigned moff) {
    const GAS char* vt2 = vt + (size_t)64 * SEQ * 2;
    asm volatile("s_nop 4\n\tglobal_load_dwordx4 %0, %3, %5\n\tglobal_load_dwordx4 %1, %3, %6\n\tglobal_load_dword %2, %4, %7" : "=&v"(a), "=&v"(b), "=&v"(m) : "v"(voff), "v"(moff), "s"(vt), "s"(vt2), "s"(mp) : "memory");
}
template <int N> __device__ __forceinline__ void ad_wait2(u32x4& a, u32x4& b) { asm volatile("s_waitcnt vmcnt(%2)" : "+v"(a), "+v"(b) : "i"(N) : "memory"); }
template <int N> __device__ __forceinline__ void ad_wait3(u32x4& a, u32x4& b, unsigned& m) { asm volatile("s_waitcnt vmcnt(%3)" : "+v"(a), "+v"(b), "+v"(m) : "i"(N) : "memory"); }
__device__ __forceinline__ float cnd_mask(float s, float neg, unsigned long long m) { float d; asm volatile("v_cndmask_b32 %0, %1, %2, %3" : "=v"(d) : "v"(neg), "v"(s), "s"(m)); return d; }
__device__ __forceinline__ void attn_dense_unit(int unit, LAS unsigned char* lds, const GAS bf16_t* aq, const GAS bf16_t* ak, const GAS bf16_t* vT, const GAS unsigned* maskT, GAS bf16_t* oatt,
                                                int tid_, int lane_, int wave) {
    int tid = tid_, lane = lane_; asm volatile("" : "+v"(tid), "+v"(lane));
    const int b = unit >> 7, g = (unit >> 6) & 1, jb = unit & 63;
    const int hd = wave & 3, qs = wave >> 2, r = lane & 31, h = lane >> 5;
    const size_t rb = (size_t)b * SEQ; const int q = 64 * jb + 32 * qs + r;
    const float CS = 0.12751743f;
    bf16x8 Bq[8];
    { const GAS bf16_t* qp = aq + (rb + q) * 1024 + (4 * g + hd) * 128 + 8 * h;
#pragma unroll
      for (int ks = 0; ks < 8; ++ks) Bq[ks] = *(const GAS bf16x8*)(qp + ks * 16); }
    f32x16 O[4];
#pragma unroll
    for (int d = 0; d < 4; ++d)
#pragma unroll
        for (int i = 0; i < 16; ++i) O[d][i] = 0.f;
    float mrow = -1e30f, lsum = 0.f;
    const GAS unsigned* mk = maskT + ((size_t)b * 128 + 2 * jb + qs) * 4096;
    const GAS bf16_t* kbase = ak + rb * 256 + g * 128;
    const GAS bf16_t* vbase = vT + ((size_t)b * 2 + g) * 128 * SEQ;
    u32x4 sk0, sk1, sv0, sv1;
    const int ntile = jb + 1;
    const unsigned koff = (unsigned)(((tid >> 4) * 256 + 8 * (tid & 15)) * 2), voff = (unsigned)(((tid >> 3) * SEQ + 8 * (tid & 7)) * 2);
#define AD_LOADK(j) do { const GAS char* kt_ = (const GAS char*)kbase + (size_t)(j) * (64 * 256 * 2); \
        sk0 = *(const GAS u32x4*)(kt_ + koff); sk1 = *(const GAS u32x4*)(kt_ + 32 * 256 * 2 + koff); } while (0)
#define AD_LOADV(j) do { const GAS char* vt_ = (const GAS char*)vbase + (size_t)(j) * (64 * 2); \
        sv0 = *(const GAS u32x4*)(vt_ + voff); sv1 = *(const GAS u32x4*)(vt_ + (size_t)64 * SEQ * 2 + voff); } while (0)
#define AD_STOREK(bufp) do { const int c0 = tid, c1 = tid + 512; LAS unsigned char* kb_ = (bufp); \
        { const int key = c0 >> 4, ch = c0 & 15; *(LAS u32x4*)(kb_ + key * 256 + ((ch ^ (key & 15)) << 4)) = sk0; } \
        { const int key = c1 >> 4, ch = c1 & 15; *(LAS u32x4*)(kb_ + key * 256 + ((ch ^ (key & 15)) << 4)) = sk1; } } while (0)
#define AD_STOREV(bufp) do { const int c0 = tid, c1 = tid + 512; LAS unsigned char* vb_ = (bufp) + 16384; \
        { const int dim = c0 >> 3, k8 = c0 & 7, s0 = 4 * (k8 >> 1) + (k8 & 1), s1 = s0 + 2, sw = (dim >> 1) & 7; \
          *(LAS u32x2*)(vb_ + dim * 128 + ((((s0 >> 1) ^ sw) << 4) | ((s0 & 1) << 3))) = (u32x2){sv0.x, sv0.y}; *(LAS u32x2*)(vb_ + dim * 128 + ((((s1 >> 1) ^ sw) << 4) | ((s1 & 1) << 3))) = (u32x2){sv0.z, sv0.w}; } \
        { const int dim = c1 >> 3, k8 = c1 & 7, s0 = 4 * (k8 >> 1) + (k8 & 1), s1 = s0 + 2, sw = (dim >> 1) & 7; \
          *(LAS u32x2*)(vb_ + dim * 128 + ((((s0 >> 1) ^ sw) << 4) | ((s0 & 1) << 3))) = (u32x2){sv1.x, sv1.y}; *(LAS u32x2*)(vb_ + dim * 128 + ((((s1 >> 1) ^ sw) << 4) | ((s1 & 1) << 3))) = (u32x2){sv1.z, sv1.w}; } } while (0)
#define AD_BAR() do { asm volatile("" ::: "memory"); __builtin_amdgcn_s_barrier(); asm volatile("" ::: "memory"); } while (0)
    const unsigned moff = (unsigned)lane * 4u; unsigned mw = mk[lane], mwn;
    AD_LOADK(0); AD_LOADV(0); AD_STOREK(lds); AD_STOREV(lds);
    asm volatile("" : "+v"(mw) : "v"(Bq[0]), "v"(Bq[1]), "v"(Bq[2]), "v"(Bq[3]), "v"(Bq[4]), "v"(Bq[5]), "v"(Bq[6]), "v"(Bq[7]));
    ad_ldk(sk0, sk1, (const GAS char*)kbase + (size_t)(1 < ntile ? 1 : 0) * (64 * 256 * 2), koff);
    LDS_WAIT(); AD_BAR();
    if (qs) AD_BAR();
#pragma unroll 1
    for (int j = 0; j < ntile; ++j) {
        LAS unsigned char* kb = lds + (j & 1) * 32768; LAS unsigned char* vb = kb + 16384;
        { const int jn = j + 1 < ntile ? j + 1 : j;
          ad_ldvm(sv0, sv1, mwn, (const GAS char*)vbase + (size_t)jn * (64 * 2), voff, (const GAS char*)(mk + 64 * jn), moff); }
        f32x16 S[2];
#pragma unroll
        for (int kbk = 0; kbk < 2; ++kbk) {
#pragma unroll
            for (int i = 0; i < 16; ++i) S[kbk][i] = 0.f;
            asm volatile("" : "+v"(S[kbk]));
            const int key = 32 * kbk + r;
#pragma unroll
            for (int kq = 0; kq < 2; ++kq) {
                bf16x8 Af[4];
#pragma unroll
                for (int k4 = 0; k4 < 4; ++k4) Af[k4] = *(const LAS bf16x8*)(kb + key * 256 + (((2 * (4 * kq + k4) + h) ^ (key & 15)) << 4));
                __builtin_amdgcn_sched_barrier(0);
#pragma unroll
                for (int k4 = 0; k4 < 4; ++k4) S[kbk] = __builtin_amdgcn_mfma_f32_32x32x16_bf16(Af[k4], Bq[4 * kq + k4], S[kbk], 0, 0, 0);
            }
        }
        const float NEG = -__builtin_inff();
        float tmax = -1e30f;
#pragma unroll
        for (int kbk = 0; kbk < 2; ++kbk)
#pragma unroll
            for (int i = 0; i < 16; ++i) {
                const unsigned tm = (unsigned)__builtin_amdgcn_sbfe((int)mw, 16 * kbk + i, 1);
                const float si = S[kbk][i];
                const float sv = __builtin_bit_cast(float, (__builtin_bit_cast(unsigned, si) & tm) | (0xFF800000u & ~tm));
                S[kbk][i] = sv; tmax = fmaxf(tmax, sv);
            }
        tmax = fmaxf(tmax, __shfl_xor(tmax, 32));
        const float mnew = fmaxf(mrow, tmax), alpha = __builtin_amdgcn_exp2f((mrow - mnew) * CS), mc = mnew * CS;
        mrow = mnew;
        ad_wait2<3>(sk0, sk1);
        if (j + 1 < ntile) AD_STOREK(lds + ((j + 1) & 1) * 32768);
        LDS_WAIT(); AD_BAR();
        { const int jn = j + 2 < ntile ? j + 2 : ntile - 1; ad_ldk(sk0, sk1, (const GAS char*)kbase + (size_t)jn * (64 * 256 * 2), koff); }
        if (!__all(alpha == 1.0f)) {
#pragma unroll
            for (int d = 0; d < 4; ++d)
#pragma unroll
                for (int i = 0; i < 16; ++i) O[d][i] *= alpha;
        }
        float psum = 0.f;
#pragma unroll
        for (int s4 = 0; s4 < 4; ++s4) {
            const int kbk = s4 >> 1, s2 = s4 & 1;
            bf16x8 Vf[4];
#pragma unroll
            for (int d = 0; d < 4; ++d) { const int dim = 32 * d + r; Vf[d] = *(const LAS bf16x8*)(vb + dim * 128 + (((2 * s4 + h) ^ ((dim >> 1) & 7)) << 4)); }
            float pe[8];
#pragma unroll
            for (int i = 0; i < 8; ++i) { pe[i] = __builtin_amdgcn_exp2f(S[kbk][8 * s2 + i] * CS - mc); psum += pe[i]; }
            u32x4 w; w.x = cvt_pk_bf16(pe[0], pe[1]); w.y = cvt_pk_bf16(pe[2], pe[3]); w.z = cvt_pk_bf16(pe[4], pe[5]); w.w = cvt_pk_bf16(pe[6], pe[7]);
            const bf16x8 Pf = __builtin_bit_cast(bf16x8, w);
#pragma unroll
            for (int d = 0; d < 4; ++d) O[d] = __builtin_amdgcn_mfma_f32_32x32x16_bf16(Vf[d], Pf, O[d], 0, 0, 0);
        }
        lsum = lsum * alpha + psum;
        ad_wait3<2>(sv0, sv1, mwn);
        if (j + 1 < ntile) AD_STOREV(lds + ((j + 1) & 1) * 32768);
        mw = mwn;
        LDS_WAIT(); AD_BAR();
    }
    ad_wait2<0>(sk0, sk1);
    if (!qs) AD_BAR();
    lsum += __shfl_xor(lsum, 32);
    const float inv = 1.0f / lsum;
    GAS bf16_t* op = oatt + (rb + q) * 1024 + (4 * g + hd) * 128 + 4 * h;
#pragma unroll
    for (int d = 0; d < 4; ++d)
#pragma unroll
        for (int i4 = 0; i4 < 4; ++i4) { u32x2 w; w.x = cvt_pk_bf16(O[d][4 * i4] * inv, O[d][4 * i4 + 1] * inv); w.y = cvt_pk_bf16(O[d][4 * i4 + 2] * inv, O[d][4 * i4 + 3] * inv);
            *(GAS u32x2*)(op + 32 * d + 8 * i4) = w; }
}

struct Args { const float* in[18]; float* out; unsigned char* ws; int ph_lo, ph_hi; };
constexpr int PH_PER_LAYER = 11, N_PHASES = 2 * PH_PER_LAYER + 1;

struct Args;
#define LDP(i) ({ const unsigned long long _v = PT[i]; const unsigned _l = __builtin_amdgcn_readfirstlane((unsigned)_v), _h = __builtin_amdgcn_readfirstlane((unsigned)(_v >> 32)); (((unsigned long long)_h << 32) | _l); })
#define INP(i) ((const GAS float*)LDP(i))
#define PHASE_IDS const int lane_ = lane_id_fresh(); const int lane = lane_, wave = wave0, tid = wave0 * 64 + lane_, gw = blockIdx.x * 8 + wave0; (void)lane; (void)gw; (void)tid; \
    GAS unsigned char* ws = (GAS unsigned char*)LDP(19); GAS u64* ssq = (GAS u64*)(ws + WS_CTL + CTL_SSQ); (void)ssq;
#define IN(k) (lo <= (k) && (k) < hi)
#define SEAM(k) do { if (IN(k) && IN((k) + 1)) { XcdBarrier b2; b2.bar = (GAS unsigned*)((GAS unsigned char*)LDP(19) + WS_CTL) + CW_BAR; b2.x = bar_x; b2.st = LCTL; xcd_barrier(b2, wave0 * 64 + lane_id_fresh()); } } while (0)

template <int l>
__device__ __forceinline__ void layer_phases(LAS unsigned char* lds, volatile LAS unsigned* LCTL, volatile LAS unsigned long long* PT, const unsigned bar_x, const int wave0, const int lo, const int hi, const int G, const int NGW) {
    constexpr int P0 = l * PH_PER_LAYER;
        if (IN(P0 + 0)) {
            PHASE_IDS
            LAS float* scr = (LAS float*)(lds + wave * 16384);
            const size_t lF = (size_t)l * DM * DFF, lI = (size_t)l * DM * IN_COLS;
            conv_job<1>(INP(2) + lF, INP(3) + lF, INP(1) + l * DM, (GAS bf16_t*)(ws + WS_WUP1), DM, DFF, N_UP, scr, gw, NGW, lane);
            conv_job<0>(INP(4) + lF, nullptr, nullptr, (GAS bf16_t*)(ws + WS_WDN1), DFF, DM, DM, scr, gw, NGW, lane);
            conv_job<2>(INP(6) + lI, nullptr, INP(5) + l * DM, (GAS bf16_t*)(ws + WS_WIN), DM, IN_COLS, N_IN, scr, gw, NGW, lane);
            conv_job<0>(INP(10) + (size_t)l * 1024 * DM, nullptr, nullptr, (GAS bf16_t*)(ws + WS_WUA), 1024, DM, DM, scr, gw, NGW, lane);
            conv_job<0>(INP(11) + (size_t)l * 1024 * DM, nullptr, nullptr, (GAS bf16_t*)(ws + WS_WUG), 1024, DM, DM, scr, gw, NGW, lane);
            conv_job<0>(INP(12) + (size_t)l * DM * DM, nullptr, nullptr, (GAS bf16_t*)(ws + WS_WOUT), DM, DM, DM, scr, gw, NGW, lane);
            conv_job<1>(INP(14) + lF, INP(15) + lF, INP(13) + l * DM, (GAS bf16_t*)(ws + WS_WUP2), DM, DFF, N_UP, scr, gw, NGW, lane);
            conv_job<0>(INP(16) + lF, nullptr, nullptr, (GAS bf16_t*)(ws + WS_WDN2), DFF, DM, DM, scr, gw, NGW, lane);
            if (l == 0) {
                GAS float* tab = (GAS float*)(ws + WS_TAB); GAS bf16_t* xb = (GAS bf16_t*)(ws + WS_XB);
                for (int i = blockIdx.x * 512 + tid; i < 65536 + 32768; i += G * 512) {
                    const bool isA = i < 65536; const int j = isA ? i : i - 65536; const int t = isA ? (j >> 4) : (j >> 3), f = isA ? (j & 15) : (j & 7);
                    const float inv = powf(500000.0f, -(float)(2 * f) / (isA ? 32.0f : 16.0f));
                    const float ang = (float)t * inv;
                    const double ad = (double)ang; const double nrev = rint(ad * 0.15915494309189535); const float rr = (float)(ad - nrev * 6.283185307179586);
                    const float c = cosf(rr), s = sinf(rr);
                    if (isA) { tab[j] = c; tab[65536 + j] = s; } else { tab[131072 + j] = c; tab[163840 + j] = s; }
                }
                const GAS float* x = INP(0);
                for (int r = gw; r < NT; r += NGW) {
                    float s = 0.f;
#pragma unroll
                    for (int j = 0; j < 4; ++j) { const size_t off = (size_t)r * DM + j * 512 + 8 * lane;
                        const f32x4 v0 = *(const GAS f32x4*)(x + off), v1 = *(const GAS f32x4*)(x + off + 4);
                        s += (v0[0] * v0[0] + v0[1] * v0[1]) + (v0[2] * v0[2] + v0[3] * v0[3]) + (v1[0] * v1[0] + v1[1] * v1[1]) + (v1[2] * v1[2] + v1[3] * v1[3]);
                        *(GAS u32x4*)(xb + off) = pack8(v0, v1); }
                    s = wave_sum(s);
                    if (lane == 0) ssq[r] = ssq_fix(s);
                }
            }
            __syncthreads();
        }
        SEAM(P0 + 0);
        if (IN(P0 + 1)) {
            PHASE_IDS
            pg8::Gemm g{(const GAS bf16_t*)(ws + WS_XB), (const GAS bf16_t*)(ws + WS_WUP1), NT, N_UP, DM}; pg8::StaticOrder S; S.init(NT, N_UP, G, (int)blockIdx.x);
            fill_rs((LAS float*)(lds + LDS_RS), ssq + (size_t)(3 * l + 0) * NT, S, tid);
            EpiUp E{(GAS bf16_t*)(ws + WS_ACT), (const LAS float*)(lds + LDS_RS)};
            pg8::gemm_phase<EpiUp>(lds, g, S, E, tid);
        }
        SEAM(P0 + 1);
        if (IN(P0 + 2)) {
            PHASE_IDS
            GAS float* out = (GAS float*)LDP(18);
            pg8::Gemm g{(const GAS bf16_t*)(ws + WS_ACT), (const GAS bf16_t*)(ws + WS_WDN1), NT, DM, DFF}; pg8::StaticOrder S; S.init(NT, DM, G, (int)blockIdx.x);
            EpiRes E{(GAS bf16_t*)(ws + WS_XB), ssq + (size_t)(3 * l + 1) * NT, 0.5f};
            pg8::gemm_phase<EpiRes>(lds, g, S, E, tid);
        }
        SEAM(P0 + 2);
        if (IN(P0 + 3)) {
            PHASE_IDS
            pg8::Gemm g{(const GAS bf16_t*)(ws + WS_XB), (const GAS bf16_t*)(ws + WS_WIN), NT, N_IN, DM}; pg8::StaticOrder S; S.init(NT, N_IN, G, (int)blockIdx.x);
            fill_rs((LAS float*)(lds + LDS_RS), ssq + (size_t)(3 * l + 1) * NT, S, tid);
            EpiIn E{(const LAS float*)(lds + LDS_RS), ws, (const GAS float*)(ws + WS_TAB)};
            pg8::gemm_phase<EpiIn>(lds, g, S, E, tid);
        }
        SEAM(P0 + 3);
        if (IN(P0 + 4)) {
            PHASE_IDS
            idx_phase(lds, (const GAS bf16_t*)(ws + WS_IQ), (const GAS bf16_t*)(ws + WS_IK), (const GAS float*)(ws + WS_IW), (GAS float*)(ws + WS_SCR), (GAS unsigned*)(ws + WS_MASK + (size_t)l * 8 * MiB), G, tid, lane, wave);
            __syncthreads();
            vt_phase(lds, (const GAS bf16_t*)(ws + WS_AV), (GAS bf16_t*)(ws + WS_AVT), G, tid);
            __syncthreads();
            gla_a_phase(lds, (const GAS bf16_t*)(ws + WS_GQ), (const GAS bf16_t*)(ws + WS_GK), (const GAS bf16_t*)(ws + WS_GV), (const GAS float*)(ws + WS_GA),
                        INP(7) + (size_t)l * 16 * 512, INP(8) + (size_t)l * 512,
                        (GAS bf16_t*)(ws + WS_QB), (GAS bf16_t*)(ws + WS_KDT), (GAS bf16_t*)(ws + WS_VT), (GAS bf16_t*)(ws + WS_ATF), (GAS float*)(ws + WS_DEC), G, tid, lane, wave);
        }
        SEAM(P0 + 4);
        if (IN(P0 + 5)) {
            PHASE_IDS
            for (int uw = blockIdx.x; uw < 256; uw += G) {
                const int unit = ((2 * (uw & 7) + (uw >> 7)) << 4) | ((uw >> 3) & 15);
                gla_b_unit(unit, wave, lds, (const GAS bf16_t*)(ws + WS_QB), (const GAS bf16_t*)(ws + WS_KDT), (const GAS bf16_t*)(ws + WS_VT), (const GAS bf16_t*)(ws + WS_ATF), (const GAS float*)(ws + WS_DEC),
                           (GAS float*)(ws + WS_OGRAW), lane);
                __syncthreads(); }
            for (int pr = blockIdx.x; pr < 256; pr += G) {
                const int bg = pr >> 5, jq = pr & 31;
#pragma unroll 1
                for (int it = 0; it < 2; ++it) {
                    attn_dense_unit(bg * 64 + (it ? 63 - jq : jq), lds, (const GAS bf16_t*)(ws + WS_AQ), (const GAS bf16_t*)(ws + WS_AK), (const GAS bf16_t*)(ws + WS_AVT),
                                    (const GAS unsigned*)(ws + WS_MASK + (size_t)l * 8 * MiB), (GAS bf16_t*)(ws + WS_OATT), tid, lane, wave);
                }
            }
        }
        SEAM(P0 + 5);
        if (IN(P0 + 6)) {
            PHASE_IDS
            const GAS float* ograw = (const GAS float*)(ws + WS_OGRAW); const GAS bf16_t* gr = (const GAS bf16_t*)(ws + WS_GR); GAS bf16_t* og = (GAS bf16_t*)(ws + WS_OG);
            const GAS float* gnorm = INP(9) + l * 256;
            for (int r = gw; r < NT; r += NGW) {
                const size_t off = (size_t)r * 1024 + 16 * lane;
                f32x4 v[4]; float s = 0.f;
#pragma unroll
                for (int j = 0; j < 4; ++j) { v[j] = *(const GAS f32x4*)(ograw + off + 4 * j); s += (v[j][0] * v[j][0] + v[j][1] * v[j][1]) + (v[j][2] * v[j][2] + v[j][3] * v[j][3]); }
                s += __shfl_xor(s, 1); s += __shfl_xor(s, 2); s += __shfl_xor(s, 4); s += __shfl_xor(s, 8);
                const float rs = rsqrtf(s * (1.0f / 256.0f) + EPS);
                f32x4 g0, g1, g2, g3; unpack8(*(const GAS u32x4*)(gr + off), g0, g1); unpack8(*(const GAS u32x4*)(gr + off + 8), g2, g3);
                const GAS float* gn = gnorm + ((16 * lane) & 255);
                const f32x4 n0 = *(const GAS f32x4*)gn, n1 = *(const GAS f32x4*)(gn + 4), n2 = *(const GAS f32x4*)(gn + 8), n3 = *(const GAS f32x4*)(gn + 12);
                *(GAS u32x4*)(og + off) = pack8(v[0] * rs * n0 * g0, v[1] * rs * n1 * g1);
                *(GAS u32x4*)(og + off + 8) = pack8(v[2] * rs * n2 * g2, v[3] * rs * n3 * g3);
            }
            pg8::Gemm g{(const GAS bf16_t*)(ws + WS_OATT), (const GAS bf16_t*)(ws + WS_WUA), NT, DM, 1024}; pg8::StaticOrder S; S.init(NT, DM, G, (int)blockIdx.x);
            EpiMrg<0> E{(GAS bf16_t*)(ws + WS_SA), (const GAS bf16_t*)(ws + WS_SA)};
            pg8::gemm_phase<EpiMrg<0>>(lds, g, S, E, tid);
        }
        SEAM(P0 + 6);
        if (IN(P0 + 7)) {
            PHASE_IDS
            pg8::Gemm g{(const GAS bf16_t*)(ws + WS_OG), (const GAS bf16_t*)(ws + WS_WUG), NT, DM, 1024}; pg8::StaticOrder S; S.init(NT, DM, G, (int)blockIdx.x);
            EpiMrg<1> E{(GAS bf16_t*)(ws + WS_SA), (const GAS bf16_t*)(ws + WS_SG)};
            pg8::gemm_phase<EpiMrg<1>>(lds, g, S, E, tid);
        }
        SEAM(P0 + 7);
        if (IN(P0 + 8)) {
            PHASE_IDS
            GAS float* out = (GAS float*)LDP(18);
            pg8::Gemm g{(const GAS bf16_t*)(ws + WS_SA), (const GAS bf16_t*)(ws + WS_WOUT), NT, DM, DM}; pg8::StaticOrder S; S.init(NT, DM, G, (int)blockIdx.x);
            EpiRes E{(GAS bf16_t*)(ws + WS_XB), ssq + (size_t)(3 * l + 2) * NT, 1.0f};
            pg8::gemm_phase<EpiRes>(lds, g, S, E, tid);
        }
        SEAM(P0 + 8);
        if (IN(P0 + 9)) {
            PHASE_IDS
            pg8::Gemm g{(const GAS bf16_t*)(ws + WS_XB), (const GAS bf16_t*)(ws + WS_WUP2), NT, N_UP, DM}; pg8::StaticOrder S; S.init(NT, N_UP, G, (int)blockIdx.x);
            fill_rs((LAS float*)(lds + LDS_RS), ssq + (size_t)(3 * l + 2) * NT, S, tid);
            EpiUp E{(GAS bf16_t*)(ws + WS_ACT), (const LAS float*)(lds + LDS_RS)};
            pg8::gemm_phase<EpiUp>(lds, g, S, E, tid);
        }
        SEAM(P0 + 9);
        if (IN(P0 + 10)) {
            PHASE_IDS
            GAS float* out = (GAS float*)LDP(18);
            pg8::Gemm g{(const GAS bf16_t*)(ws + WS_ACT), (const GAS bf16_t*)(ws + WS_WDN2), NT, DM, DFF}; pg8::StaticOrder S; S.init(NT, DM, G, (int)blockIdx.x);
            EpiRes E{(GAS bf16_t*)(ws + WS_XB), ssq + (size_t)(3 * l + 3) * NT, 0.5f};
            pg8::gemm_phase<EpiRes>(lds, g, S, E, tid);
        }
        SEAM(P0 + 10);
}

__global__ void __launch_bounds__(512, 2) mega_fwd(Args a) {
    extern __shared__ __attribute__((aligned(16))) unsigned char lds_raw[];
    LAS unsigned char* lds = (LAS unsigned char*)lds_raw;
    const int G = gridDim.x, NGW = G * 8;
    volatile LAS unsigned* LCTL = (volatile LAS unsigned*)(lds + LDS_STAGE);
    volatile LAS unsigned long long* PT = (volatile LAS unsigned long long*)(lds + LDS_STAGE + 64);
    if (threadIdx.x < 16) LCTL[threadIdx.x] = 0u;
    if (threadIdx.x == 64) {
#pragma unroll
        for (int i = 0; i < 18; ++i) PT[i] = (unsigned long long)a.in[i];
        PT[18] = (unsigned long long)a.out; PT[19] = (unsigned long long)a.ws;
    }
    __syncthreads();
    XcdBarrier bar = xcd_barrier_post((GAS unsigned*)(a.ws + WS_CTL) + CW_BAR, LCTL);
    const int lo = MK_PER_PHASE ? a.ph_lo : 0, hi = MK_PER_PHASE ? a.ph_hi : N_PHASES; const unsigned bar_x = bar.x; const int wave0 = __builtin_amdgcn_readfirstlane((int)threadIdx.x >> 6);
    layer_phases<0>(lds, LCTL, PT, bar.x, wave0, lo, hi, G, NGW);
    layer_phases<1>(lds, LCTL, PT, bar.x, wave0, lo, hi, G, NGW);
    if (IN(2 * PH_PER_LAYER)) {
        PHASE_IDS
        GAS float* out = (GAS float*)LDP(18);
        const GAS float* fn = INP(17); const GAS u64* sq = ssq + (size_t)6 * NT;
        const GAS bf16_t* xb = (const GAS bf16_t*)(ws + WS_XB);
        for (int r = gw; r < NT; r += NGW) {
            const float rs = rstd_of(sq, r);
#pragma unroll
            for (int j = 0; j < 4; ++j) { const int c = j * 512 + 8 * lane; GAS float* p = out + (size_t)r * DM + c;
                f32x4 v0, v1; unpack8(*(const GAS u32x4*)(xb + (size_t)r * DM + c), v0, v1);
                *(GAS f32x4*)p = v0 * rs * *(const GAS f32x4*)(fn + c); *(GAS f32x4*)(p + 4) = v1 * rs * *(const GAS f32x4*)(fn + c + 4); }
        }
    }
#undef IN
#undef SEAM
}

extern "C" void kernel_launch(void* const* d_in, const int* in_sizes, int n_in, void* d_out, int out_size, void* d_ws, size_t ws_size, hipStream_t stream) {
    static int grid = 0;
    if (grid == 0) {
        if (n_in != 18 || in_sizes[0] != NT * DM || out_size != NT * DM || ws_size < WS_END) {
            fprintf(stderr, "kernel_launch: unexpected problem shape (n_in %d, in0 %d, out %d, ws %zu < %zu); nothing launched\n", n_in, n_in > 0 ? in_sizes[0] : -1, out_size, ws_size, (size_t)WS_END);
            grid = -1; return; }
        int dev = 0, cus = 0, per_cu = 0;
        if (hipGetDevice(&dev) != hipSuccess || hipDeviceGetAttribute(&cus, hipDeviceAttributeMultiprocessorCount, dev) != hipSuccess) { grid = -1; return; }
        if (hipFuncSetAttribute((const void*)mega_fwd, hipFuncAttributeMaxDynamicSharedMemorySize, LDS_BYTES) != hipSuccess) { fprintf(stderr, "kernel_launch: hipFuncSetAttribute failed\n"); grid = -1; return; }
        if (hipOccupancyMaxActiveBlocksPerMultiprocessor(&per_cu, (const void*)mega_fwd, 512, LDS_BYTES) != hipSuccess || per_cu < 1)
            fprintf(stderr, "kernel_launch: occupancy query reports %d workgroups per CU\n", per_cu);
        (void)hipGetLastError();
        grid = cus;
        if (grid > 256) grid = 256;
    }
    if (grid < 0) return;
    if (hipMemsetAsync((char*)d_ws + WS_CTL, 0, CTL_BYTES, stream) != hipSuccess) { fprintf(stderr, "kernel_launch: memset failed\n"); return; }
    Args a{};
    for (int i = 0; i < 18; ++i) a.in[i] = (const float*)d_in[i];
    a.out = (float*)d_out; a.ws = (unsigned char*)d_ws;
#if MK_PER_PHASE
    for (int p = 0; p < N_PHASES; ++p) { a.ph_lo = p; a.ph_hi = p + 1; hipLaunchKernelGGL(mega_fwd, dim3(grid), dim3(512), LDS_BYTES, stream, a); }
#else
    a.ph_lo = 0; a.ph_hi = N_PHASES;
    hipLaunchKernelGGL(mega_fwd, dim3(grid), dim3(512), LDS_BYTES, stream, a);
#endif
    const hipError_t le = hipPeekAtLastError();
    if (le != hipSuccess) fprintf(stderr, "kernel_launch: launch failed: %s\n", hipGetErrorName(le));
}
```
